# Optimizing an MI355X kernel written in HIP

```python
import math
import jax, jax.numpy as jnp
from jax import lax
import numpy as np

D_MODEL = 1024
BATCH = 4
SEQ = 8192
DEPTH = 1

N_HEADS = 16
HEAD_DIM = 64
N_KV_GROUPS = 4
HEADS_PER_GROUP = N_HEADS // N_KV_GROUPS
CMP_BLOCK = 32
CMP_STRIDE = 16
CMP_HIDDEN = 256
SEL_BLOCK = 64
N_SELECT = 16
WINDOW = 512
NSA_Q_BLOCK = 64
FORCE = 1e4
CONV_DIM = D_MODEL
CONV_WIDTH = 3
N_MEM = 256
MEM_HEADS = 4
MEM_HEAD_DIM = D_MODEL // MEM_HEADS
REL_BUCKETS = 32
REL_MAX_DIST = 128
D_FF = 2816
EPS = 1e-6
NEG = -1e30

NSA_WIDTH = N_HEADS * HEAD_DIM
KV_WIDTH = N_KV_GROUPS * HEAD_DIM
MEM_WIDTH = MEM_HEADS * MEM_HEAD_DIM
IN_SPLITS = (NSA_WIDTH, 6 * KV_WIDTH, 3 * N_HEADS, 3 * CONV_DIM, MEM_WIDTH, 3 * D_MODEL)
IN_WIDTH = NSA_WIDTH + 6 * KV_WIDTH + 3 * N_HEADS + 3 * CONV_DIM + MEM_WIDTH + 3 * D_MODEL

kernel_name = "hybrid_nsa_shortconv_memory_macaron"


def rmsnorm(x, g):
    xf = x.astype(jnp.float32)
    y = xf * lax.rsqrt(jnp.mean(xf * xf, axis=-1, keepdims=True) + EPS)
    return (y * g.astype(jnp.float32)).astype(x.dtype)


def swiglu_ffn(h, w_in, w_out):
    a, b = jnp.split(h @ w_in, 2, axis=-1)
    return (jax.nn.silu(a) * b) @ w_out


def masked_softmax(s, valid):
    return jax.nn.softmax(jnp.where(valid, s.astype(jnp.float32), NEG), axis=-1)


def rel_bucket(dist):
    n = jnp.maximum(dist, 0)
    max_exact = REL_BUCKETS // 2
    nf = jnp.maximum(n, 1).astype(jnp.float32)
    large = max_exact + (jnp.log(nf / max_exact) / math.log(REL_MAX_DIST / max_exact)
                         * (REL_BUCKETS - max_exact)).astype(jnp.int32)
    large = jnp.minimum(large, REL_BUCKETS - 1)
    return jnp.where(n < max_exact, n, large)


def compress(kv, pe, w1, w2):
    b, s, g, d = kv.shape
    ratio = CMP_BLOCK // CMP_STRIDE
    n_chunks = s // CMP_STRIDE
    chunks = kv.reshape(b, n_chunks, CMP_STRIDE, g, d)
    blocks = jnp.concatenate([chunks[:, r:n_chunks - ratio + 1 + r] for r in range(ratio)], axis=2)
    blocks = blocks + pe[None, None, :, None, :]
    n_cmp = blocks.shape[1]
    flat = blocks.transpose(0, 1, 3, 2, 4).reshape(b, n_cmp, g, CMP_BLOCK * d)
    return jax.nn.silu(flat @ w1) @ w2


def cmp_to_sel_matrix(n_cmp, n_sel):
    cs = jnp.arange(n_cmp)[:, None] * CMP_STRIDE
    ss = jnp.arange(n_sel)[None, :] * SEL_BLOCK
    ov = jnp.maximum(jnp.minimum(cs + CMP_BLOCK, ss + SEL_BLOCK) - jnp.maximum(cs, ss), 0)
    return ov.astype(jnp.float32) / CMP_BLOCK


def nsa_attention(q, k_cmp, v_cmp, k_slc, v_slc, k_win, v_win, gates, rel_bias):
    b, s, h, d = q.shape
    g, r = N_KV_GROUPS, HEADS_PER_GROUP
    n_cmp = k_cmp.shape[1]
    n_sel = s // SEL_BLOCK
    top = min(N_SELECT, n_sel)
    scale = d ** -0.5
    qg = q.reshape(b, s, g, r, d)
    gg = gates.reshape(b, s, g, r, 3)
    bias_grk = rel_bias.reshape(REL_BUCKETS, g, r).transpose(1, 0, 2)
    sel_map = cmp_to_sel_matrix(n_cmp, n_sel)
    cmp_end = jnp.arange(n_cmp) * CMP_STRIDE + CMP_BLOCK - 1
    ks_blocks = k_slc.reshape(b, n_sel, SEL_BLOCK, g, d).transpose(0, 3, 1, 2, 4)
    vs_blocks = v_slc.reshape(b, n_sel, SEL_BLOCK, g, d).transpose(0, 3, 1, 2, 4)
    pad = ((0, 0), (WINDOW, 0), (0, 0), (0, 0))
    kw_pad = jnp.pad(k_win, pad)
    vw_pad = jnp.pad(v_win, pad)
    bi = jnp.arange(b)[:, None, None, None]
    gi = jnp.arange(g)[None, :, None, None]

    def dense_bias(dist):
        qn, kn = dist.shape
        return rel_bias[rel_bucket(dist)].reshape(qn, kn, g, r).transpose(2, 3, 0, 1)

    def block(i):
        s0 = i * NSA_Q_BLOCK
        t = s0 + jnp.arange(NSA_Q_BLOCK)
        qb = lax.dynamic_slice_in_dim(qg, s0, NSA_Q_BLOCK, axis=1)
        gb = lax.dynamic_slice_in_dim(gg, s0, NSA_Q_BLOCK, axis=1)
        valid_c = cmp_end[None, :] <= t[:, None]
        s_c = jnp.einsum('bqgrd,bcgd->bgrqc', qb, k_cmp) * scale + dense_bias(t[:, None] - cmp_end[None, :])
        p_c = masked_softmax(s_c, valid_c) * jnp.any(valid_c, axis=-1)[:, None].astype(jnp.float32)
        o_c = jnp.einsum('bgrqc,bcgd->bqgrd', p_c.astype(v_cmp.dtype), v_cmp)
        imp = jnp.einsum('bgrqc,cn->bgqn', p_c, sel_map)
        blk = jnp.arange(n_sel)[None, :]
        cur = (t // SEL_BLOCK)[:, None]
        valid_b = blk <= cur
        forced = (blk == 0) | (blk == cur) | (blk == cur - 1)
        score = jnp.where(valid_b, imp + jnp.where(forced, FORCE, 0.0), -FORCE)
        _, idx = lax.top_k(score, top)
        ks = ks_blocks[bi, gi, idx].reshape(b, g, NSA_Q_BLOCK, top * SEL_BLOCK, d)
        vs = vs_blocks[bi, gi, idx].reshape(b, g, NSA_Q_BLOCK, top * SEL_BLOCK, d)
        pos = (idx[..., None] * SEL_BLOCK + jnp.arange(SEL_BLOCK)).reshape(b, g, NSA_Q_BLOCK, top * SEL_BLOCK)
        dist_s = t[None, None, :, None] - pos
        bias_s = bias_grk[gi, rel_bucket(dist_s)].transpose(0, 1, 4, 2, 3)
        s_s = jnp.einsum('bqgrd,bgqtd->bgrqt', qb, ks) * scale + bias_s
        p_s = masked_softmax(s_s, (dist_s >= 0)[:, :, None])
        o_s = jnp.einsum('bgrqt,bgqtd->bqgrd', p_s.astype(vs.dtype), vs)
        kw = lax.dynamic_slice_in_dim(kw_pad, s0, NSA_Q_BLOCK + WINDOW, axis=1)
        vw = lax.dynamic_slice_in_dim(vw_pad, s0, NSA_Q_BLOCK + WINDOW, axis=1)
        kp = s0 - WINDOW + jnp.arange(NSA_Q_BLOCK + WINDOW)
        dist_w = t[:, None] - kp[None, :]
        valid_w = (kp[None, :] >= 0) & (dist_w >= 0) & (dist_w < WINDOW)
        s_w = jnp.einsum('bqgrd,bkgd->bgrqk', qb, kw) * scale + dense_bias(dist_w)
        p_w = masked_softmax(s_w, valid_w)
        o_w = jnp.einsum('bgrqk,bkgd->bqgrd', p_w.astype(vw.dtype), vw)
        return gb[..., 0:1] * o_c + gb[..., 1:2] * o_s + gb[..., 2:3] * o_w

    out = lax.map(block, jnp.arange(s // NSA_Q_BLOCK))
    return out.transpose(1, 0, 2, 3, 4, 5).reshape(b, s, h * d)


def short_gated_conv(conv_in, conv_w, conv_b):
    gate_b, gate_c, x_in = jnp.split(conv_in, 3, axis=-1)
    u = gate_c * x_in
    y = lax.conv_general_dilated(u, conv_w[:, None, :], window_strides=(1,),
                                 padding=((CONV_WIDTH - 1, 0),),
                                 dimension_numbers=('NWC', 'WIO', 'NWC'),
                                 feature_group_count=u.shape[-1])
    return gate_b * (y + conv_b)


def memory_attention(q_mem, mem, mem_norm_g, w_mem_kv, q_g, k_g):
    b, s, _ = q_mem.shape
    m = mem.shape[1]
    km, vm = jnp.split(rmsnorm(mem, mem_norm_g) @ w_mem_kv, 2, axis=-1)
    km = rmsnorm(km.reshape(b, m, MEM_HEADS, MEM_HEAD_DIM), k_g)
    vm = vm.reshape(b, m, MEM_HEADS, MEM_HEAD_DIM)
    qm = rmsnorm(q_mem.reshape(b, s, MEM_HEADS, MEM_HEAD_DIM), q_g)
    sm = jnp.einsum('bshd,bmhd->bhsm', qm, km) * MEM_HEAD_DIM ** -0.5
    pm = jax.nn.softmax(sm.astype(jnp.float32), axis=-1).astype(vm.dtype)
    return jnp.einsum('bhsm,bmhd->bshd', pm, vm).reshape(b, s, MEM_WIDTH)


def hybrid_layer(x, mem, ffn1_norm_g, ffn1_w_in, ffn1_w_out, mix_norm_g, w_in, q_norm_g, k_norm_g,
                 cmp_pe_k, cmp_w1_k, cmp_w2_k, cmp_pe_v, cmp_w1_v, cmp_w2_v, conv_w, conv_b,
                 mem_norm_g, w_mem_kv, mem_q_norm_g, mem_k_norm_g, w_out,
                 ffn2_norm_g, ffn2_w_in, ffn2_w_out, rel_bias):
    b, s, _ = x.shape
    x = x + 0.5 * swiglu_ffn(rmsnorm(x, ffn1_norm_g), ffn1_w_in, ffn1_w_out)
    h = rmsnorm(x, mix_norm_g)
    split_points = np.cumsum(IN_SPLITS)[:-1].tolist()
    q, kv, nsa_g, conv_in, q_mem, merge_g = jnp.split(h @ w_in, split_points, axis=-1)
    q = rmsnorm(q.reshape(b, s, N_HEADS, HEAD_DIM), q_norm_g)
    kc, vc, ks, vs, kw, vw = [t.reshape(b, s, N_KV_GROUPS, HEAD_DIM) for t in jnp.split(kv, 6, axis=-1)]
    k_cmp = rmsnorm(compress(kc, cmp_pe_k, cmp_w1_k, cmp_w2_k), k_norm_g)
    v_cmp = compress(vc, cmp_pe_v, cmp_w1_v, cmp_w2_v)
    gates = jax.nn.sigmoid(nsa_g.astype(jnp.float32)).astype(x.dtype).reshape(b, s, N_HEADS, 3)
    o_nsa = nsa_attention(q, k_cmp, v_cmp, rmsnorm(ks, k_norm_g), vs, rmsnorm(kw, k_norm_g), vw,
                          gates, rel_bias)
    o_conv = short_gated_conv(conv_in, conv_w, conv_b)
    o_mem = memory_attention(q_mem, mem, mem_norm_g, w_mem_kv, mem_q_norm_g, mem_k_norm_g)
    g_nsa, g_conv, g_mem = jnp.split(jax.nn.sigmoid(merge_g.astype(jnp.float32)).astype(x.dtype), 3, axis=-1)
    x = x + (g_nsa * o_nsa + g_conv * o_conv + g_mem * o_mem) @ w_out
    x = x + 0.5 * swiglu_ffn(rmsnorm(x, ffn2_norm_g), ffn2_w_in, ffn2_w_out)
    return x


def setup_inputs(seed: int = 0) -> dict:
    key = jax.random.key(seed)
    keys = iter(jax.random.split(key, 32))
    L = DEPTH

    def nrm(shape, scale):
        return jax.random.normal(next(keys), shape, jnp.float32) * scale

    def w(shape, fan_in):
        return nrm(shape, fan_in ** -0.5)

    def gain(shape):
        return 1.0 + nrm(shape, 0.05)

    return {
        "x": nrm((BATCH, SEQ, D_MODEL), 1.0),
        "mem": nrm((BATCH, N_MEM, D_MODEL), 1.0),
        "ffn1_norm_g": gain((L, D_MODEL)),
        "ffn1_w_in": w((L, D_MODEL, 2 * D_FF), D_MODEL),
        "ffn1_w_out": w((L, D_FF, D_MODEL), D_FF),
        "mix_norm_g": gain((L, D_MODEL)),
        "w_in": w((L, D_MODEL, IN_WIDTH), D_MODEL),
        "q_norm_g": gain((L, HEAD_DIM)),
        "k_norm_g": gain((L, HEAD_DIM)),
        "cmp_pe_k": nrm((L, CMP_BLOCK, HEAD_DIM), 0.1),
        "cmp_w1_k": w((L, CMP_BLOCK * HEAD_DIM, CMP_HIDDEN), CMP_BLOCK * HEAD_DIM),
        "cmp_w2_k": w((L, CMP_HIDDEN, HEAD_DIM), CMP_HIDDEN),
        "cmp_pe_v": nrm((L, CMP_BLOCK, HEAD_DIM), 0.1),
        "cmp_w1_v": w((L, CMP_BLOCK * HEAD_DIM, CMP_HIDDEN), CMP_BLOCK * HEAD_DIM),
        "cmp_w2_v": w((L, CMP_HIDDEN, HEAD_DIM), CMP_HIDDEN),
        "conv_w": w((L, CONV_WIDTH, CONV_DIM), CONV_WIDTH),
        "conv_b": nrm((L, CONV_DIM), 0.02),
        "mem_norm_g": gain((L, D_MODEL)),
        "w_mem_kv": w((L, D_MODEL, 2 * MEM_WIDTH), D_MODEL),
        "mem_q_norm_g": gain((L, MEM_HEAD_DIM)),
        "mem_k_norm_g": gain((L, MEM_HEAD_DIM)),
        "w_out": w((L, D_MODEL, D_MODEL), D_MODEL),
        "ffn2_norm_g": gain((L, D_MODEL)),
        "ffn2_w_in": w((L, D_MODEL, 2 * D_FF), D_MODEL),
        "ffn2_w_out": w((L, D_FF, D_MODEL), D_FF),
        "rel_bias": nrm((REL_BUCKETS, N_HEADS), 0.5),
    }


def reference(x, mem, ffn1_norm_g, ffn1_w_in, ffn1_w_out, mix_norm_g, w_in, q_norm_g, k_norm_g,
              cmp_pe_k, cmp_w1_k, cmp_w2_k, cmp_pe_v, cmp_w1_v, cmp_w2_v, conv_w, conv_b,
              mem_norm_g, w_mem_kv, mem_q_norm_g, mem_k_norm_g, w_out,
              ffn2_norm_g, ffn2_w_in, ffn2_w_out, rel_bias):
    for l in range(DEPTH):
        x = hybrid_layer(x, mem, ffn1_norm_g[l], ffn1_w_in[l], ffn1_w_out[l], mix_norm_g[l], w_in[l],
                         q_norm_g[l], k_norm_g[l], cmp_pe_k[l], cmp_w1_k[l], cmp_w2_k[l],
                         cmp_pe_v[l], cmp_w1_v[l], cmp_w2_v[l], conv_w[l], conv_b[l],
                         mem_norm_g[l], w_mem_kv[l], mem_q_norm_g[l], mem_k_norm_g[l], w_out[l],
                         ffn2_norm_g[l], ffn2_w_in[l], ffn2_w_out[l], rel_bias)
    return x
```

```cpp
#include <hip/hip_runtime.h>
#include <cstdio>
#include <cstdint>

__device__ __forceinline__ int lane_fresh() { int l; asm volatile("v_mbcnt_lo_u32_b32 %0, -1, 0\n\tv_mbcnt_hi_u32_b32 %0, -1, %0" : "=v"(l)); return l; }
namespace pg8 {
#define PG8_LAS __attribute__((address_space(3)))
typedef unsigned short bf16_t;
typedef short bf16x8 __attribute__((ext_vector_type(8)));
typedef float f32x4 __attribute__((ext_vector_type(4)));
typedef unsigned u32x4 __attribute__((ext_vector_type(4)));
typedef unsigned u32x2 __attribute__((ext_vector_type(2)));
constexpr int BM = 256, BK = 64, HALF = 128, HTB = HALF * BK * 2, STAGE_BYTES = 8 * HTB, NXCD = 8, WGM = 8;

__host__ __device__ __forceinline__ int lds_byte(int r, int c) { const int st = (r >> 4) * 2 + (c >> 5), rr = r & 15, cc = c & 31, ob = rr * 64 + cc * 2; return st * 1024 + (ob ^ (((ob >> 9) & 1) << 5)); }
__host__ __device__ __forceinline__ void stage_rc(int b, int& R, int& C) { const int st = b / 1024, sb = b % 1024, swz = sb ^ (((sb >> 9) & 1) << 5); R = (st >> 1) * 16 + swz / 64; C = (st & 1) * 32 + (swz % 64) / 2; }
__host__ __device__ __forceinline__ int perm32(int rho) { const int n = rho >> 4, i = rho & 15; return 8 * (i >> 2) + 4 * n + (i & 3); }

struct Unit { int pm, pn; };
struct Gemm { const bf16_t* A; const bf16_t* Bt; int M, N, K, lda; };

struct StaticOrder {
    int nM, nN, nwg, G, c;
    __host__ __device__ void init(int M, int N, int G_, int c_) { nM = M / BM; nN = N / BM; nwg = nM * nN; G = G_; c = c_; }
    __host__ __device__ bool next(int i, Unit& u) const {
        const long L = (long)i * G + c; if (L >= nwg) return false;
        int wgid = (int)L; { const int q = nwg / NXCD, r = nwg % NXCD, xcd = wgid % NXCD, off = wgid / NXCD; wgid = (xcd < r ? xcd * (q + 1) : r * (q + 1) + (xcd - r) * q) + off; }
        const int nig = WGM * nN, gid = wgid / nig, fm = gid * WGM, gsz = (nM - fm) < WGM ? (nM - fm) : WGM;
        u.pm = fm + ((wgid % nig) % gsz); u.pn = (wgid % nig) / gsz; return true;
    }
    __device__ __forceinline__ void a_ready(const Unit&) const {}
    __device__ __forceinline__ void done(const Unit&) const {}
};
struct PairOrder {
    int nu, per, G, c;
    __device__ bool next(int i, Unit& u) const { const int L = i * G + c; if (L >= nu) return false; u.pm = L; u.pn = L / per; return true; }
    __device__ __forceinline__ void a_ready(const Unit&) const {}
    __device__ __forceinline__ void done(const Unit&) const {}
};

__device__ __forceinline__ unsigned cvt_pk_bf16(float lo, float hi) { unsigned r; asm volatile("v_cvt_pk_bf16_f32 %0, %1, %2" : "=v"(r) : "v"(lo), "v"(hi)); return r; }

template <class Epi, class Sched, bool ALIGN_EPI = false, bool SP2 = false>
__device__ __forceinline__ void gemm_phase(PG8_LAS unsigned char* lds, const Gemm g, const Sched& S, const Epi& E, const int wv) {
    const int tid = wv * 64 + lane_fresh();
    const int wid = __builtin_amdgcn_readfirstlane(tid >> 6), lane = tid & 63, wr = wid >> 2, wc = wid & 3, fr = lane & 15, fq = lane >> 4;
    const int K = g.K, nt = K / BK;
    unsigned voffA[2], voffB[2];
#pragma unroll
    for (int i = 0; i < 2; ++i) { int R, C; stage_rc(tid * 16 + i * 8192, R, C); const int Rb = Epi::PERM ? ((R & ~31) + perm32(R & 31)) : R;
        voffA[i] = (unsigned)(R * g.lda + C) * 2u; voffB[i] = (unsigned)(Rb * K + C) * 2u; }
    const size_t kstep = (size_t)(BK * 2);
    const size_t hstepA = (size_t)HALF * g.lda * 2, hstepB = (size_t)HALF * K * 2;
    const size_t tstepA = 2 * hstepA, tstepB = 2 * hstepB;
    const unsigned ldsw = (unsigned)wid * 1024u;
    const int aoff = lds_byte(wr * 64 + fr, fq * 8), boff = lds_byte(wc * 32 + fr, fq * 8);
#define PG8_SA(b, h) (((b) * 2 + (h)) * HTB)
#define PG8_SB(b, h) ((4 + (b) * 2 + (h)) * HTB)
#define PG8_STAGE(bufoff, gbase, voff) do { _Pragma("unroll") for (int _i = 0; _i < 2; ++_i) \
        __builtin_amdgcn_global_load_lds((const unsigned*)((const char*)(gbase) + (voff)[_i]), (PG8_LAS unsigned*)(lds + (bufoff) + ldsw + _i * 8192), 16, 0, 0); } while (0)
#define PG8_LDA(dst, b, h) do { _Pragma("unroll") for (int m = 0; m < 4; ++m) _Pragma("unroll") for (int k = 0; k < 2; ++k) dst[m][k] = *(const PG8_LAS bf16x8*)(lds + PG8_SA(b, h) + aoff + m * 2048 + k * 1024); } while (0)
#define PG8_LDB(dst, b, h) do { _Pragma("unroll") for (int n = 0; n < 2; ++n) _Pragma("unroll") for (int k = 0; k < 2; ++k) dst[n][k] = *(const PG8_LAS bf16x8*)(lds + PG8_SB(b, h) + boff + n * 2048 + k * 1024); } while (0)
#define PG8_MMA(ai, bj, At, Bt) do { __builtin_amdgcn_s_setprio(1); _Pragma("unroll") for (int m = 0; m < 4; ++m) _Pragma("unroll") for (int n = 0; n < 2; ++n) _Pragma("unroll") for (int k = 0; k < 2; ++k) \
        acc[ai][bj][m][n] = __builtin_amdgcn_mfma_f32_16x16x32_bf16(Bt[n][k], At[m][k], acc[ai][bj][m][n], 0, 0, 0); __builtin_amdgcn_s_setprio(0); } while (0)
#define PG8_WAIT_V(n) asm volatile("s_waitcnt vmcnt(" #n ")" ::: "memory")
#define PG8_WAIT_L(n) asm volatile("s_waitcnt lgkmcnt(" #n ")" ::: "memory")
#define PG8_BAR __builtin_amdgcn_s_barrier()
#define PG8_SCHED __builtin_amdgcn_sched_barrier(0)
    Unit cur, nxt; int ui = 0;
    if (!S.next(0, cur)) return;
    f32x4 acc[2][2][4][2];
#pragma unroll
    for (int a = 0; a < 2; ++a)
#pragma unroll
        for (int b = 0; b < 2; ++b)
#pragma unroll
            for (int m = 0; m < 4; ++m)
#pragma unroll
                for (int n = 0; n < 2; ++n) acc[a][b][m][n] = (f32x4){0.f, 0.f, 0.f, 0.f};
    bf16x8 At[4][2], B0[2][2], B1[2][2];
    const char* cA = (const char*)g.A + (size_t)cur.pm * tstepA; const char* cB = (const char*)g.Bt + (size_t)cur.pn * tstepB;
    S.a_ready(cur);
    if constexpr (SP2) {
        PG8_STAGE(PG8_SB(0, 0), cB, voffB); PG8_STAGE(PG8_SB(0, 1), cB + hstepB, voffB); PG8_STAGE(PG8_SA(0, 0), cA, voffA); PG8_STAGE(PG8_SA(0, 1), cA + hstepA, voffA);
        if (wr == 1) PG8_BAR;
        PG8_WAIT_V(2); PG8_BAR;
        PG8_STAGE(PG8_SB(1, 0), cB + kstep, voffB); PG8_STAGE(PG8_SA(1, 0), cA + kstep, voffA); PG8_STAGE(PG8_SB(1, 1), cB + hstepB + kstep, voffB);
        PG8_WAIT_V(6); PG8_BAR;
    } else {
        PG8_STAGE(PG8_SB(0, 0), cB, voffB); PG8_STAGE(PG8_SA(0, 0), cA, voffA); PG8_STAGE(PG8_SB(0, 1), cB + hstepB, voffB); PG8_STAGE(PG8_SA(0, 1), cA + hstepA, voffA);
        if (wr == 1) PG8_BAR;
        PG8_WAIT_V(4); PG8_BAR;
        PG8_STAGE(PG8_SB(1, 0), cB + kstep, voffB); PG8_STAGE(PG8_SA(1, 0), cA + kstep, voffA); PG8_STAGE(PG8_SB(1, 1), cB + hstepB + kstep, voffB);
        PG8_WAIT_V(6); PG8_BAR;
    }
    for (;;) {
        const bool has_next = S.next(ui + 1, nxt);
        const char* nA = has_next ? (const char*)g.A + (size_t)nxt.pm * tstepA : cA; const char* nB = has_next ? (const char*)g.Bt + (size_t)nxt.pn * tstepB : cB;
        for (int t = 0; t < nt; t += 2) {
            const bool last = (t == nt - 2);
            const char* a1 = cA + (size_t)(t + 1) * kstep;
            const char* a2 = last ? nA : cA + (size_t)(t + 2) * kstep; const char* b2 = last ? nB : cB + (size_t)(t + 2) * kstep;
            const char* a3 = a2 + kstep; const char* b3 = b2 + kstep;
            if (last && has_next) S.a_ready(nxt);
            if constexpr (SP2) {
            PG8_LDB(B0, 0, 0); PG8_LDB(B1, 0, 1); PG8_SCHED; PG8_LDA(At, 0, 0); PG8_STAGE(PG8_SA(1, 1), a1 + hstepA, voffA);
            PG8_WAIT_V(8); PG8_WAIT_L(0); PG8_BAR; PG8_MMA(0, 0, At, B0); PG8_MMA(0, 1, At, B1); PG8_BAR; PG8_SCHED;
            PG8_LDA(At, 0, 1); PG8_STAGE(PG8_SB(0, 0), b2, voffB); PG8_STAGE(PG8_SB(0, 1), b2 + hstepB, voffB); PG8_STAGE(PG8_SA(0, 0), a2, voffA);
            PG8_WAIT_V(8); PG8_WAIT_L(0); PG8_BAR; PG8_MMA(1, 0, At, B0); PG8_MMA(1, 1, At, B1); PG8_BAR; PG8_SCHED;
            PG8_LDB(B0, 1, 0); PG8_LDB(B1, 1, 1); PG8_SCHED; PG8_LDA(At, 1, 0); PG8_STAGE(PG8_SA(0, 1), a2 + hstepA, voffA);
            PG8_WAIT_V(8); PG8_WAIT_L(0); PG8_BAR; PG8_MMA(0, 0, At, B0); PG8_MMA(0, 1, At, B1); PG8_BAR; PG8_SCHED;
            PG8_LDA(At, 1, 1); PG8_STAGE(PG8_SB(1, 0), b3, voffB); PG8_STAGE(PG8_SB(1, 1), b3 + hstepB, voffB); PG8_STAGE(PG8_SA(1, 0), a3, voffA);
            PG8_WAIT_V(8); PG8_WAIT_L(0); PG8_BAR; PG8_MMA(1, 0, At, B0); PG8_MMA(1, 1, At, B1); PG8_BAR; PG8_SCHED;
            } else {
            PG8_LDB(B0, 0, 0); PG8_SCHED; PG8_LDA(At, 0, 0); PG8_STAGE(PG8_SA(1, 1), a1 + hstepA, voffA);
            PG8_WAIT_L(8); PG8_BAR; PG8_WAIT_L(0); PG8_MMA(0, 0, At, B0); PG8_BAR; PG8_SCHED;
            PG8_LDB(B1, 0, 1); PG8_STAGE(PG8_SB(0, 0), b2, voffB);
            PG8_BAR; PG8_WAIT_L(0); PG8_MMA(0, 1, At, B1); PG8_BAR;
            PG8_LDA(At, 0, 1); PG8_STAGE(PG8_SA(0, 0), a2, voffA);
            PG8_BAR; PG8_WAIT_L(0); PG8_MMA(1, 0, At, B0); PG8_BAR; PG8_SCHED;
            PG8_STAGE(PG8_SB(0, 1), b2 + hstepB, voffB);
            PG8_WAIT_V(6); PG8_BAR; PG8_MMA(1, 1, At, B1); PG8_BAR;
            PG8_LDB(B0, 1, 0); PG8_SCHED; PG8_LDA(At, 1, 0); PG8_STAGE(PG8_SA(0, 1), a2 + hstepA, voffA);
            PG8_WAIT_L(8); PG8_BAR; PG8_WAIT_L(0); PG8_MMA(0, 0, At, B0); PG8_BAR; PG8_SCHED;
            PG8_LDB(B1, 1, 1); PG8_STAGE(PG8_SB(1, 0), b3, voffB);
            PG8_BAR; PG8_WAIT_L(0); PG8_MMA(0, 1, At, B1); PG8_BAR;
            PG8_LDA(At, 1, 1); PG8_STAGE(PG8_SA(1, 0), a3, voffA);
            PG8_BAR; PG8_WAIT_L(0); PG8_MMA(1, 0, At, B0); PG8_BAR; PG8_SCHED;
            PG8_STAGE(PG8_SB(1, 1), b3 + hstepB, voffB);
            PG8_WAIT_V(6); PG8_BAR; PG8_MMA(1, 1, At, B1); PG8_BAR;
            }
        }
        if constexpr (ALIGN_EPI) { if (wr == 0) PG8_BAR; }
        E(acc, cur, wr, wc, fr, fq); S.done(cur);
        if (!has_next) break;
#pragma unroll
        for (int a = 0; a < 2; ++a)
#pragma unroll
            for (int b = 0; b < 2; ++b)
#pragma unroll
                for (int m = 0; m < 4; ++m)
#pragma unroll
                    for (int n = 0; n < 2; ++n) acc[a][b][m][n] = (f32x4){0.f, 0.f, 0.f, 0.f};
        cur = nxt; cA = nA; cB = nB; ++ui;
        if constexpr (ALIGN_EPI) { if (wr == 1) PG8_BAR; }
    }
    PG8_WAIT_V(0);
    if constexpr (!ALIGN_EPI) { if (wr == 0) PG8_BAR; }
    PG8_BAR;
#undef PG8_SA
#undef PG8_SB
#undef PG8_STAGE
#undef PG8_LDA
#undef PG8_LDB
#undef PG8_MMA
#undef PG8_WAIT_V
#undef PG8_WAIT_L
#undef PG8_BAR
#undef PG8_SCHED
}
}

typedef unsigned short bf16;
typedef float f32x4 __attribute__((ext_vector_type(4)));
typedef unsigned u32x4 __attribute__((ext_vector_type(4)));
typedef unsigned u32x2 __attribute__((ext_vector_type(2)));
#define LAS __attribute__((address_space(3)))

constexpr int DM = 1024, NB = 4, SEQ = 8192, T = NB * SEQ;
constexpr int NH = 16, HD = 64, NG = 4, HPG = 4;
constexpr int NCMP = 511, NCMPP = 512;
constexpr int NSELB = 128, NTOP = 16, WIN = 512;
constexpr int NMEM = 256, MH = 4, MHD = 256;
constexpr int FF = 2816, FF2 = 5632;
constexpr int INW = 9776;
constexpr int NT_IN = 39, INWP = NT_IN * 256;
constexpr float EPS = 1e-6f;
constexpr float LOG2E = 1.4426950408889634f;
constexpr int NCHUNK = 1, TC = T / NCHUNK, BPC = NB / NCHUNK;
constexpr int C_Q = 0, C_KV = 1024, C_NG = 2560, C_GB = 2608, C_GC = 3632, C_XI = 4656, C_QM = 5680, C_MG = 6704;
constexpr int TQ0 = 0, TKV0 = 4, TNG = 10, TCU0 = 11, TGB0 = 19, TQM0 = 23, TMG0 = 27;

constexpr size_t MiB = 1u << 20;
constexpr size_t WS_CTL = 0;
constexpr size_t OFF_SSQ0 = 64 * 1024;
constexpr size_t OFF_SSQ1 = OFF_SSQ0 + (size_t)T * 4;
constexpr size_t OFF_SSQ2 = OFF_SSQ1 + (size_t)T * 4;
constexpr size_t OFF_BIAS1 = OFF_SSQ2 + (size_t)T * 4;
constexpr size_t OFF_WC2T = OFF_BIAS1 + 512 * 4;
constexpr size_t WS_SMALL_END = 1 * MiB;
static_assert(OFF_WC2T + 2 * 64 * 256 * 2 <= WS_SMALL_END, "small region");
constexpr size_t WS_W1T = 1 * MiB;
constexpr size_t WS_W2T = WS_W1T + (size_t)FF2 * DM * 2;
constexpr size_t WS_WINT = WS_W2T + (size_t)DM * FF * 2;
constexpr size_t WS_WOT = WS_WINT + (size_t)INWP * DM * 2;
constexpr size_t WS_W3T = WS_WOT + (size_t)DM * DM * 2;
constexpr size_t WS_W4T = WS_W3T + (size_t)FF2 * DM * 2;
constexpr size_t WS_WC1T = WS_W4T + (size_t)DM * FF * 2;
constexpr size_t WS_WMKVT = WS_WC1T + (size_t)512 * 2048 * 2;
constexpr size_t WS_MEMN = WS_WMKVT + (size_t)2048 * 1024 * 2;
constexpr size_t WS_KM = WS_MEMN + (size_t)1024 * 1024 * 2;
constexpr size_t WS_VM = WS_KM + (size_t)1024 * 1024 * 2;
constexpr size_t WS_KCMP = WS_VM + (size_t)1024 * 1024 * 2;
constexpr size_t WS_HID = WS_KCMP + (size_t)2 * BPC * NG * NCMPP * 64 * 2;
constexpr size_t WS_WEND = WS_HID + (size_t)2 * BPC * NG * NCMPP * 256 * 2;
static_assert(WS_WEND <= 84 * MiB, "weights region");
constexpr size_t WS_A = 84 * MiB;
constexpr size_t WS_MG = WS_A;
constexpr size_t WS_U = WS_MG + (size_t)TC * 3072;
constexpr size_t WS_GATES = WS_U + (size_t)TC * 1024 * 2;
static_assert(WS_GATES + (size_t)TC * 48 * 4 <= WS_A + 192 * MiB && (size_t)T * FF * 2 <= 192 * MiB, "region A");
constexpr size_t WS_XB = WS_A + 192 * MiB;
constexpr size_t WS_KV = WS_XB + 64 * MiB;
constexpr size_t KVSZ = (size_t)BPC * NG * SEQ * 64;
constexpr size_t WS_GB = WS_KV + 6 * KVSZ * 2 + 64 * 1024;
constexpr size_t WS_MERGED = WS_GB;
constexpr size_t WS_END = WS_GB + (size_t)T * 1024 * 2;
static_assert(WS_END <= 512 * MiB, "workspace map must fit 512 MiB");

constexpr int RING_BYTES = 131072;
constexpr int LDS_BYTES = 147456;

__device__ __forceinline__ float bf2f(unsigned short v) { return __uint_as_float((unsigned)v << 16); }
__device__ __forceinline__ unsigned f2bf(float f) { unsigned u = __float_as_uint(f); return (u + 0x7fffu + ((u >> 16) & 1u)) >> 16; }
typedef __bf16 bf16x2v_t __attribute__((ext_vector_type(2))); typedef float f32x2v_t __attribute__((ext_vector_type(2)));
__device__ __forceinline__ unsigned pk2(float lo, float hi) { return __builtin_bit_cast(unsigned, __builtin_convertvector((f32x2v_t){lo, hi}, bf16x2v_t)); }
template <int CTRL> __device__ __forceinline__ float dppf(float x) { return __builtin_bit_cast(float, __builtin_amdgcn_mov_dpp(__builtin_bit_cast(int, x), CTRL, 0xf, 0xf, true)); }
__device__ __forceinline__ float xor16f(float x) { return __builtin_bit_cast(float, __builtin_amdgcn_ds_swizzle(__builtin_bit_cast(int, x), 0x401F)); }
__device__ __forceinline__ float half_lo(float x, float& hi_) { auto rr = __builtin_amdgcn_permlane32_swap(__float_as_uint(x), __float_as_uint(x), false, false); hi_ = __uint_as_float(rr[1]); return __uint_as_float(rr[0]); }
__device__ __forceinline__ float wave_sum(float v) {
    v += dppf<0xB1>(v); v += dppf<0x4E>(v); v += dppf<0x141>(v); v += dppf<0x140>(v); v += xor16f(v);
    float h; const float l = half_lo(v, h); return l + h;
}
__device__ __forceinline__ float wave_max(float v) {
    v = fmaxf(v, dppf<0xB1>(v)); v = fmaxf(v, dppf<0x4E>(v)); v = fmaxf(v, dppf<0x141>(v)); v = fmaxf(v, dppf<0x140>(v)); v = fmaxf(v, xor16f(v));
    float h; const float l = half_lo(v, h); return fmaxf(l, h);
}
__device__ __forceinline__ float fast_exp2(float x) { return __builtin_amdgcn_exp2f(x); }
__device__ __forceinline__ float fast_rcp(float x) { return __builtin_amdgcn_rcpf(x); }
__device__ __forceinline__ float sigmoidf_(float v) { return fast_rcp(1.f + fast_exp2(-v * LOG2E)); }
__device__ __forceinline__ float siluf_(float v) { return v * sigmoidf_(v); }
__device__ __forceinline__ void unpack8(const u32x4 w, float* f) {
    f[0] = __uint_as_float(w.x << 16); f[1] = __uint_as_float(w.x & 0xffff0000u);
    f[2] = __uint_as_float(w.y << 16); f[3] = __uint_as_float(w.y & 0xffff0000u);
    f[4] = __uint_as_float(w.z << 16); f[5] = __uint_as_float(w.z & 0xffff0000u);
    f[6] = __uint_as_float(w.w << 16); f[7] = __uint_as_float(w.w & 0xffff0000u);
}

struct Args {
    const float* in[26];
    float* out;
    unsigned char* ws;
};
enum { I_X = 0, I_MEM, I_F1G, I_F1WI, I_F1WO, I_MIXG, I_WIN, I_QG, I_KG, I_PEK, I_W1K, I_W2K, I_PEV, I_W1V, I_W2V, I_CONVW, I_CONVB,
       I_MEMG, I_WMKV, I_MQG, I_MKG, I_WOUT, I_F2G, I_F2WI, I_F2WO, I_RELB };

__device__ __forceinline__ int src_swiglu(int n) { return ((n & 128) ? FF : 0) + 128 * (n >> 8) + (n & 127); }
__device__ __forceinline__ int src_win(int n) {
    const int pn = n >> 8, c = n & 255;
    if (pn < TKV0) return C_Q + 64 * (4 * pn + ((c >> 5) & 3)) + 32 * (c >> 7) + (c & 31);
    if (pn < TNG) return C_KV + 256 * (pn - TKV0) + 64 * ((c >> 5) & 3) + 32 * (c >> 7) + (c & 31);
    if (pn == TNG) return c < 48 ? C_NG + c : -1;
    if (pn < TGB0) return ((c & 128) ? C_XI : C_GC) + 128 * (pn - TCU0) + (c & 127);
    if (pn < TQM0) return C_GB + 256 * (pn - TGB0) + c;
    if (pn < TMG0) return C_QM + 256 * (pn - TQM0) + c;
    return C_MG + 256 * (pn - TMG0) + c;
}

template <int MAP>
__device__ __forceinline__ void transpose_item64(const float* W, int K, int N, const float* gk, bf16* WT, LAS float* scr, int item, int lane) {
    const int kblocks = K / 64, nb = item / kblocks, kb = item % kblocks, k0 = 64 * kb, n0 = 64 * nb;
    const int nq = (lane & 15) * 4, kr = lane >> 4, n = n0 + nq;
    const int src = (MAP == 0) ? n : (MAP == 1) ? src_swiglu(n) : src_win(n);
    f32x4 v[16];
#pragma unroll
    for (int i = 0; i < 16; ++i) { const int kk = 4 * i + kr; v[i] = (src >= 0) ? *(const f32x4*)(W + (size_t)(k0 + kk) * N + src) : (f32x4){0.f, 0.f, 0.f, 0.f}; }
#pragma unroll
    for (int i = 0; i < 16; ++i) { const int kk = 4 * i + kr; const float g = gk ? gk[k0 + kk] : 1.f;
        LAS float* d = scr + kk * 65 + nq; d[0] = v[i][0] * g; d[1] = v[i][1] * g; d[2] = v[i][2] * g; d[3] = v[i][3] * g; }
    asm volatile("s_waitcnt lgkmcnt(0)" ::: "memory");
    const int c = lane & 7;
#pragma unroll
    for (int j = 0; j < 8; ++j) { const int nn = (lane >> 3) + 8 * j; const LAS float* sp = scr + (8 * c) * 65 + nn;
        u32x4 o; o.x = pk2(sp[0 * 65], sp[1 * 65]); o.y = pk2(sp[2 * 65], sp[3 * 65]); o.z = pk2(sp[4 * 65], sp[5 * 65]); o.w = pk2(sp[6 * 65], sp[7 * 65]);
        *(u32x4*)(WT + (size_t)(n0 + nn) * K + k0 + 8 * c) = o; }
    asm volatile("s_waitcnt lgkmcnt(0)" ::: "memory");
}


struct EpiSwiglu {
    static constexpr bool PERM = true;
    bf16* act; const float* ssq;
    __device__ __forceinline__ void operator()(const f32x4 (&acc)[2][2][4][2], const pg8::Unit& u, int wr, int wc, int fr, int fq) const {
        float rsv[8];
#pragma unroll
        for (int i = 0; i < 8; ++i) rsv[i] = ssq[u.pm * 256 + (i >> 2) * 128 + wr * 64 + (i & 3) * 16 + fr];
#pragma unroll
        for (int ai = 0; ai < 2; ++ai)
#pragma unroll
            for (int m = 0; m < 4; ++m) {
                const int row = u.pm * 256 + ai * 128 + wr * 64 + m * 16 + fr;
                const float rs = rsqrtf(rsv[ai * 4 + m] * (1.f / DM) + EPS);
                float o[8];
#pragma unroll
                for (int n = 0; n < 2; ++n)
#pragma unroll
                    for (int e = 0; e < 4; ++e) { const float a = acc[ai][0][m][n][e] * rs, b = acc[ai][1][m][n][e] * rs; o[4 * n + e] = siluf_(a) * b; }
                u32x4 w; w.x = pk2(o[0], o[1]); w.y = pk2(o[2], o[3]); w.z = pk2(o[4], o[5]); w.w = pk2(o[6], o[7]);
                *(u32x4*)(act + (size_t)row * FF + u.pn * 128 + wc * 32 + fq * 8) = w;
            }
    }
};

template <bool LAST> struct EpiResidB {
    static constexpr bool PERM = true;
    bf16* xb; float alpha; float* ssq; float* out;
    __device__ __forceinline__ void operator()(const f32x4 (&acc)[2][2][4][2], const pg8::Unit& u, int wr, int wc, int fr, int fq) const {
        u32x4 bs[16];
#pragma unroll
        for (int i = 0; i < 16; ++i) { const int row = u.pm * 256 + (i >> 3) * 128 + wr * 64 + ((i >> 1) & 3) * 16 + fr;
            bs[i] = *(const u32x4*)(xb + (size_t)row * DM + u.pn * 256 + (i & 1) * 128 + wc * 32 + fq * 8); }
#pragma unroll
        for (int ai = 0; ai < 2; ++ai)
#pragma unroll
            for (int m = 0; m < 4; ++m) {
                const int row = u.pm * 256 + ai * 128 + wr * 64 + m * 16 + fr;
                float ss = 0.f;
#pragma unroll
                for (int bj = 0; bj < 2; ++bj) {
                    const size_t off = (size_t)row * DM + u.pn * 256 + bj * 128 + wc * 32 + fq * 8;
                    float b[8]; unpack8(bs[ai * 8 + m * 2 + bj], b);
                    float v[8];
#pragma unroll
                    for (int e = 0; e < 4; ++e) { v[e] = b[e] + alpha * acc[ai][bj][m][0][e]; v[4 + e] = b[4 + e] + alpha * acc[ai][bj][m][1][e]; }
                    if (LAST) { *(f32x4*)(out + off) = (f32x4){v[0], v[1], v[2], v[3]}; *(f32x4*)(out + off + 4) = (f32x4){v[4], v[5], v[6], v[7]}; }
                    else {
#pragma unroll
                        for (int e = 0; e < 8; ++e) ss += v[e] * v[e];
                        u32x4 w; w.x = pk2(v[0], v[1]); w.y = pk2(v[2], v[3]); w.z = pk2(v[4], v[5]); w.w = pk2(v[6], v[7]);
                        *(u32x4*)(xb + off) = w; }
                }
                if (!LAST) { ss += xor16f(ss); { float h_; const float l_ = half_lo(ss, h_); ss = l_ + h_; } if (fq == 0) atomicAdd(ssq + row, ss); }
            }
    }
};

struct EpiMemKV {
    static constexpr bool PERM = true;
    bf16* km; bf16* vm;
    __device__ __forceinline__ void operator()(const f32x4 (&acc)[2][2][4][2], const pg8::Unit& u, int wr, int wc, int fr, int fq) const {
        const int hm = u.pn & 3;
#pragma unroll
        for (int ai = 0; ai < 2; ++ai)
#pragma unroll
            for (int m = 0; m < 4; ++m) {
                const int row = u.pm * 256 + ai * 128 + wr * 64 + m * 16 + fr; const int b = row >> 8, mm = row & 255;
#pragma unroll
                for (int bj = 0; bj < 2; ++bj) {
                    const f32x4 v0 = acc[ai][bj][m][0], v1 = acc[ai][bj][m][1];
                    if (u.pn < 4) {
                        u32x4 w; w.x = pk2(v0[0], v0[1]); w.y = pk2(v0[2], v0[3]); w.z = pk2(v1[0], v1[1]); w.w = pk2(v1[2], v1[3]);
                        *(u32x4*)(km + ((size_t)(b * MH + hm) * NMEM + mm) * MHD + bj * 128 + wc * 32 + fq * 8) = w;
                    } else {
                        const int mp = (mm & ~12) | ((mm & 4) << 1) | ((mm & 8) >> 1);
                        bf16* vt = vm + ((size_t)(b * MH + hm) * MHD + bj * 128 + wc * 32 + fq * 8) * NMEM + mp;
#pragma unroll
                        for (int e = 0; e < 4; ++e) { vt[(size_t)e * NMEM] = (bf16)f2bf(v0[e]); vt[(size_t)(4 + e) * NMEM] = (bf16)f2bf(v1[e]); }
                    }
                }
            }
    }
};

struct EpiHid {
    static constexpr bool PERM = true;
    bf16* hid; const float* bias;
    __device__ __forceinline__ void operator()(const f32x4 (&acc)[2][2][4][2], const pg8::Unit& u, int wr, int wc, int fr, int fq) const {
#pragma unroll
        for (int bj = 0; bj < 2; ++bj) {
            const f32x4 b0 = *(const f32x4*)(bias + u.pn * 256 + bj * 128 + wc * 32 + fq * 8), b1 = *(const f32x4*)(bias + u.pn * 256 + bj * 128 + wc * 32 + fq * 8 + 4);
#pragma unroll
            for (int ai = 0; ai < 2; ++ai)
#pragma unroll
                for (int m = 0; m < 4; ++m) {
                    const int row = u.pm * 256 + ai * 128 + wr * 64 + m * 16 + fr;
                    float o[8];
#pragma unroll
                    for (int e = 0; e < 4; ++e) { o[e] = siluf_(acc[ai][bj][m][0][e] + b0[e]); o[4 + e] = siluf_(acc[ai][bj][m][1][e] + b1[e]); }
                    u32x4 w; w.x = pk2(o[0], o[1]); w.y = pk2(o[2], o[3]); w.z = pk2(o[4], o[5]); w.w = pk2(o[6], o[7]);
                    *(u32x4*)(hid + (size_t)row * 256 + bj * 128 + wc * 32 + fq * 8) = w;
                }
        }
    }
};

constexpr float QSCALE = 0.125f * LOG2E;

struct EpiMix {
    static constexpr bool PERM = true;
    const float* ssq;
    const float* qg; const float* kg;
    bf16* qn; bf16* kv; float* gates; bf16* u_; bf16* gb; bf16* qm; unsigned char* mg;
    __device__ __forceinline__ void operator()(const f32x4 (&acc)[2][2][4][2], const pg8::Unit& u, int wr, int wc, int fr, int fq) const {
        const int pn = u.pn;
        float gq[2][8];
        if (pn < TNG) {
            const float* gsrc = (pn < TKV0) ? qg : kg;
#pragma unroll
            for (int bj = 0; bj < 2; ++bj)
#pragma unroll
                for (int e = 0; e < 8; ++e) gq[bj][e] = gsrc[bj * 32 + fq * 8 + e];
        }
        float rsv[8];
#pragma unroll
        for (int i = 0; i < 8; ++i) rsv[i] = ssq[u.pm * 256 + (i >> 2) * 128 + wr * 64 + (i & 3) * 16 + fr];
#pragma unroll
        for (int ai = 0; ai < 2; ++ai)
#pragma unroll
            for (int m = 0; m < 4; ++m) {
                const int row = u.pm * 256 + ai * 128 + wr * 64 + m * 16 + fr;
                const float rs = rsqrtf(rsv[ai * 4 + m] * (1.f / DM) + EPS);
                float v[2][8];
#pragma unroll
                for (int bj = 0; bj < 2; ++bj)
#pragma unroll
                    for (int n = 0; n < 2; ++n)
#pragma unroll
                        for (int e = 0; e < 4; ++e) v[bj][4 * n + e] = acc[ai][bj][m][n][e] * rs;
                if (pn < TNG) {
                    const bool isq = pn < TKV0; const int kvi = pn - TKV0;
                    const bool donorm = isq || kvi == 2 || kvi == 4;
                    float ss = 0.f;
#pragma unroll
                    for (int bj = 0; bj < 2; ++bj)
#pragma unroll
                        for (int e = 0; e < 8; ++e) ss += v[bj][e] * v[bj][e];
                    ss += xor16f(ss); { float h_; const float l_ = half_lo(ss, h_); ss = l_ + h_; }
                    const float r2 = donorm ? rsqrtf(ss * (1.f / 64.f) + EPS) * (isq ? QSCALE : 1.f) : 1.f;
                    bf16* dst;
                    if (isq) dst = qn + (size_t)row * DM + (4 * pn + wc) * 64;
                    else { const int bl = row >> 13, s = row & (SEQ - 1); dst = kv + (size_t)kvi * KVSZ + ((size_t)(bl * NG + wc) * SEQ + s) * 64; }
#pragma unroll
                    for (int bj = 0; bj < 2; ++bj) {
                        float o[8];
#pragma unroll
                        for (int e = 0; e < 8; ++e) o[e] = donorm ? v[bj][e] * r2 * gq[bj][e] : v[bj][e];
                        u32x4 w; w.x = pk2(o[0], o[1]); w.y = pk2(o[2], o[3]); w.z = pk2(o[4], o[5]); w.w = pk2(o[6], o[7]);
                        *(u32x4*)(dst + bj * 32 + fq * 8) = w;
                    }
                } else if (pn == TNG) {
                    const int c0 = wc * 32 + fq * 8;
                    if (c0 < 48) {
                        f32x4 a, b;
#pragma unroll
                        for (int e = 0; e < 4; ++e) { a[e] = sigmoidf_(v[0][e]); b[e] = sigmoidf_(v[0][4 + e]); }
                        *(f32x4*)(gates + (size_t)row * 48 + c0) = a; *(f32x4*)(gates + (size_t)row * 48 + c0 + 4) = b;
                    }
                } else if (pn < TGB0) {
                    float o[8];
#pragma unroll
                    for (int e = 0; e < 8; ++e) o[e] = v[0][e] * v[1][e];
                    u32x4 w; w.x = pk2(o[0], o[1]); w.y = pk2(o[2], o[3]); w.z = pk2(o[4], o[5]); w.w = pk2(o[6], o[7]);
                    *(u32x4*)(u_ + (size_t)row * DM + (pn - TCU0) * 128 + wc * 32 + fq * 8) = w;
                } else {
                    if (pn < TMG0) {
                        bf16* dst = (pn < TQM0) ? gb + (size_t)row * DM + (pn - TGB0) * 256 : qm + (size_t)row * DM + (pn - TQM0) * 256;
#pragma unroll
                        for (int bj = 0; bj < 2; ++bj) {
                            u32x4 w; w.x = pk2(v[bj][0], v[bj][1]); w.y = pk2(v[bj][2], v[bj][3]); w.z = pk2(v[bj][4], v[bj][5]); w.w = pk2(v[bj][6], v[bj][7]);
                            *(u32x4*)(dst + bj * 128 + wc * 32 + fq * 8) = w;
                        }
                    } else {
                        unsigned char* dst = mg + (size_t)row * 3072 + (pn - TMG0) * 256;
#pragma unroll
                        for (int bj = 0; bj < 2; ++bj) {
                            unsigned q[8];
#pragma unroll
                            for (int e = 0; e < 8; ++e) q[e] = (unsigned)(sigmoidf_(v[bj][e]) * 255.f + 0.5f);
                            u32x2 w; w.x = q[0] | (q[1] << 8) | (q[2] << 16) | (q[3] << 24); w.y = q[4] | (q[5] << 8) | (q[6] << 16) | (q[7] << 24);
                            *(u32x2*)(dst + bj * 128 + wc * 32 + fq * 8) = w;
                        }
                    }
                }
            }
    }
};

__device__ __forceinline__ int rel_bucket(int n) {
    if (n < 16) return n < 0 ? 0 : n;
    if (n >= 128) return 31;
    const int b = 16 + (int)(__log2f((float)n * (1.f / 16.f)) * (16.f / 3.f));
    return b > 31 ? 31 : b;
}

typedef float f32x16 __attribute__((ext_vector_type(16)));
typedef short bf16x8_t __attribute__((ext_vector_type(8)));
typedef short v4i16_t __attribute__((ext_vector_type(4)));
typedef float f32x2_t __attribute__((ext_vector_type(2)));
typedef __bf16 bf16x2_t __attribute__((ext_vector_type(2)));
__device__ __forceinline__ unsigned cvtpk(float lo, float hi) { f32x2_t v = {lo, hi}; bf16x2_t b = __builtin_convertvector(v, bf16x2_t); return __builtin_bit_cast(unsigned, b); }
__device__ __forceinline__ int crow(int r, int hi) { return (r & 3) + 8 * (r >> 2) + 4 * hi; }
__device__ __forceinline__ unsigned cvtpk_c(float lo, float hi) { return __builtin_bit_cast(unsigned, __builtin_convertvector((f32x2v_t){lo, hi}, bf16x2v_t)); }
__device__ __forceinline__ float dpp_x1(float x) { return __builtin_bit_cast(float, __builtin_amdgcn_mov_dpp(__builtin_bit_cast(int, x), 0xB1, 0xf, 0xf, true)); }
__device__ __forceinline__ float dpp_x2(float x) { return __builtin_bit_cast(float, __builtin_amdgcn_mov_dpp(__builtin_bit_cast(int, x), 0x4E, 0xf, 0xf, true)); }
__device__ __forceinline__ float half_sum(float x) { auto rr = __builtin_amdgcn_permlane32_swap(__float_as_uint(x), __float_as_uint(x), false, false); return __uint_as_float(rr[0]) + __uint_as_float(rr[1]); }
__device__ __forceinline__ v4i16_t vtr(const LAS unsigned char* p) { return __builtin_amdgcn_ds_read_tr16_b64_v4i16((LAS v4i16_t*)p); }

__device__ __forceinline__ void glds16(const void* gsrc, unsigned lds_dst) { unsigned keep;
    asm volatile("s_mov_b32 %0, m0\n\ts_mov_b32 m0, %2\n\ts_nop 0\n\tglobal_load_lds_dwordx4 %1, off\n\ts_mov_b32 m0, %0" : "=&s"(keep) : "v"(gsrc), "s"(lds_dst) : "memory"); }
__device__ __forceinline__ void glds16s(const void* sbase, unsigned voff, unsigned lds_dst) { unsigned keep;
    asm volatile("s_mov_b32 %0, m0\n\ts_mov_b32 m0, %2\n\ts_nop 0\n\tglobal_load_lds_dwordx4 %1, %3\n\ts_mov_b32 m0, %0" : "=&s"(keep) : "v"(voff), "s"(lds_dst), "s"(sbase) : "memory"); }
constexpr int NBS = 3;
constexpr int NL_SBUF = NBS * 16384;
constexpr int LUTS = 136, RLS = 264;
constexpr int NL_IMP = 2 * NL_SBUF, NL_LUT = NL_IMP + 64 * 132 * 4, NL_SELM = NL_LUT + 4 * LUTS * 4, NL_RLUT = NL_SELM + 64 * 16, NL_END = NL_RLUT + 4 * RLS * 4;
static_assert(NL_END <= LDS_BYTES - 64, "NSA LDS map");

struct NsaU { const bf16* qn; const bf16* kv; const bf16* kcmp; const float* gates; bf16* onsa; const float* relb; float kbound; };

#define NSA_READS(kbase, vbase) v4i16_t vr_[8]; const LAS unsigned char* kb_ = (kbase); const LAS unsigned char* vb_ = (vbase)
#define NSA_VREADS01() do { _Pragma("unroll") for (int ks = 0; ks < 2; ++ks) { vr_[4 * ks] = vtr(vb_ + ks * 2048); vr_[4 * ks + 1] = vtr(vb_ + ks * 2048 + 1024); vr_[4 * ks + 2] = vtr(vb_ + ks * 2048 + VD1); vr_[4 * ks + 3] = vtr(vb_ + ks * 2048 + 1024 + VD1); } \
        } while (0)
#define NSA_QK() do { bf16x8_t ka_[8]; _Pragma("unroll") for (int s = 0; s < 4; ++s) { \
        ka_[2 * s] = *(const LAS bf16x8_t*)(kb_ + (((2 * s + hi) ^ x7) << 4)); ka_[2 * s + 1] = *(const LAS bf16x8_t*)(kb_ + 4096 + (((2 * s + hi) ^ x7) << 4)); } \
        NSA_VREADS01(); _Pragma("unroll") for (int s = 0; s < 4; ++s) { \
        p0 = __builtin_amdgcn_mfma_f32_32x32x16_bf16(ka_[2 * s], qf[s], p0, 0, 0, 0); p1 = __builtin_amdgcn_mfma_f32_32x32x16_bf16(ka_[2 * s + 1], qf[s], p1, 0, 0, 0); } \
        __builtin_amdgcn_sched_group_barrier(0x100, 16, 0); __builtin_amdgcn_sched_group_barrier(0x008, 8, 0); \
        __builtin_amdgcn_sched_barrier(0); } while (0)
#define NSA_PV() do { u32x4 pk[4]; v4i16_t vs_[8]; \
        _Pragma("unroll") for (int ks = 2; ks < 4; ++ks) { vs_[4 * ks - 8] = vtr(vb_ + ks * 2048); vs_[4 * ks - 7] = vtr(vb_ + ks * 2048 + 1024); vs_[4 * ks - 6] = vtr(vb_ + ks * 2048 + VD1); vs_[4 * ks - 5] = vtr(vb_ + ks * 2048 + 1024 + VD1); } \
        pk[0] = (u32x4){cvtpk(p0[0], p0[1]), cvtpk(p0[2], p0[3]), cvtpk(p0[4], p0[5]), cvtpk(p0[6], p0[7])}; \
        pk[1] = (u32x4){cvtpk(p0[8], p0[9]), cvtpk(p0[10], p0[11]), cvtpk(p0[12], p0[13]), cvtpk(p0[14], p0[15])}; \
        pk[2] = (u32x4){cvtpk(p1[0], p1[1]), cvtpk(p1[2], p1[3]), cvtpk(p1[4], p1[5]), cvtpk(p1[6], p1[7])}; \
        pk[3] = (u32x4){cvtpk(p1[8], p1[9]), cvtpk(p1[10], p1[11]), cvtpk(p1[12], p1[13]), cvtpk(p1[14], p1[15])}; \
        _Pragma("unroll") for (int ks = 0; ks < 4; ++ks) { \
            const v4i16_t l0 = ks < 2 ? vr_[4 * ks] : vs_[4 * ks - 8], h0 = ks < 2 ? vr_[4 * ks + 1] : vs_[4 * ks - 7], l1 = ks < 2 ? vr_[4 * ks + 2] : vs_[4 * ks - 6], h1 = ks < 2 ? vr_[4 * ks + 3] : vs_[4 * ks - 5]; \
            const bf16x8_t vf0 = (bf16x8_t){l0[0], l0[1], l0[2], l0[3], h0[0], h0[1], h0[2], h0[3]}; \
            const bf16x8_t vf1 = (bf16x8_t){l1[0], l1[1], l1[2], l1[3], h1[0], h1[1], h1[2], h1[3]}; \
            const bf16x8_t pb = __builtin_bit_cast(bf16x8_t, pk[ks]); \
            o0 = __builtin_amdgcn_mfma_f32_32x32x16_bf16(vf0, pb, o0, 0, 0, 0); o1 = __builtin_amdgcn_mfma_f32_32x32x16_bf16(vf1, pb, o1, 0, 0, 0); } } while (0)
#define NSA_SOFTMAX_GENERAL(dbase_) do { const LAS float* lutr = lut + r * LUTS; const int a_ = (dbase_) - 64 * hi + 1; _Pragma("unroll") for (int i = 0; i < 16; ++i) { \
        const int c_ = 16 * ((i & 3) + 8 * (i >> 2)); int i0 = a_ - c_, i1 = a_ - c_ - 512; i0 = i0 < 0 ? 0 : (i0 > 129 ? 129 : i0); i1 = i1 < 0 ? 0 : (i1 > 129 ? 129 : i1); \
        p0[i] = fast_exp2(p0[i] + lutr[i0]); p1[i] = fast_exp2(p1[i] + lutr[i1]); } } while (0)

#define NSA_SOFTMAX_NEAR(dbase_) do { const LAS float* rb_ = (const LAS float*)(lds + NL_RLUT) + r * RLS + (191 - (dbase_) + 4 * hi); _Pragma("unroll") for (int i = 0; i < 16; ++i) { \
        p0[i] = fast_exp2(p0[i] + rb_[(i & 3) + 8 * (i >> 2)]); p1[i] = fast_exp2(p1[i] + rb_[32 + (i & 3) + 8 * (i >> 2)]); } } while (0)
#define NSA_SOFTMAX_FARMASK(dbase_, dmax_) do { const int lo_ = (dbase_) - (dmax_) - 4 * hi; _Pragma("unroll") for (int i = 0; i < 16; ++i) { \
        const int k0 = (i & 3) + 8 * (i >> 2); p0[i] = fast_exp2(k0 >= lo_ ? p0[i] : -1e30f); p1[i] = fast_exp2(k0 + 32 >= lo_ ? p1[i] : -1e30f); } } while (0)
__device__ __forceinline__ void nsa_unit(const NsaU& P, LAS unsigned char* lds_in, int bl, int g, int qb, const int wave_in) {
    int wave = wave_in; unsigned ldsu = (unsigned)(uintptr_t)lds_in; asm volatile("" : "+s"(wave), "+s"(ldsu));
    LAS unsigned char* lds = (LAS unsigned char*)(uintptr_t)ldsu;
    const int lane = lane_fresh(), tid = wave * 64 + lane, c = lane & 31, hi = lane >> 5;
    const int tok = 8 * wave + (c >> 2), r = c & 3, t0 = qb * 64, t = t0 + tok, cur = qb;
    const size_t tl = (size_t)bl * SEQ + t;
    LAS float* imp = (LAS float*)(lds + NL_IMP); LAS float* lut = (LAS float*)(lds + NL_LUT);
    const unsigned lds0 = (unsigned)(uintptr_t)lds;
    bf16x8_t qf[4];
    { const bf16* qrow = P.qn + tl * DM + (g * 4 + r) * 64;
#pragma unroll
      for (int s = 0; s < 4; ++s) qf[s] = *(const bf16x8_t*)(qrow + 16 * s + 8 * hi); }
    const size_t segkv = (size_t)(bl * NG + g) * SEQ * 64;
    const bf16* kcseg = P.kcmp + (size_t)(bl * NG + g) * NCMPP * 64; const bf16* vcseg = kcseg + (size_t)BPC * NG * NCMPP * 64;
    const bf16* ksseg = P.kv + 2 * KVSZ + segkv; const bf16* vsseg = P.kv + 3 * KVSZ + segkv;
    const bf16* kwseg = P.kv + 4 * KVSZ + segkv; const bf16* vwseg = P.kv + 5 * KVSZ + segkv;
    const int nc = (4 * cur + 2) / 64 + 1, w0 = cur > 8 ? cur - 8 : 0, nw = cur - w0 + 1;
    const int e1 = nc, e2 = 2 * nc, e2p = ((e2 + NBS - 1) / NBS) * NBS, e3 = e2p + nw, e3p = ((e3 + NBS - 1) / NBS) * NBS, nstepsA = e3p / NBS;
    const bool wpipe = cur >= 8;
    const int nstepsG = wpipe ? e2p / NBS : nstepsA;
    const int nf = cur > 2 ? cur - 2 : 0, nfp = ((nf + NBS - 1) / NBS) * NBS, nn = cur + 1 - nf, NT = e3p + nfp + nn, nsteps = nstepsA + nfp / NBS + 1;
    const int srow = tid >> 3, sch = tid & 7;
    const int ksrc = srow * 128 + ((sch ^ ((srow >> 1) & 7)) << 4), vsrc = srow * 128 + ((sch ^ (((srow >> 1) & 1) << 2)) << 4);
    const unsigned wdst = (unsigned)wave * 1024u;
#define NSA_GATE(k_) ([&]() { const int c_ = lane_fresh() & 31; \
        return P.gates[((size_t)bl * SEQ + qb * 64 + 8 * wave + (c_ >> 2)) * 48 + (g * 4 + (c_ & 3)) * 3 + (k_)]; }())
#define NSA_PARK ((LAS unsigned*)(lds + NL_IMP) + wave * 1056 + lane)
#define NSA_STAGE(ti, sbuf, b) do { int ti_ = (ti); ti_ = ti_ < NT ? ti_ : NT - 1;              \
        const bool isc_ = ti_ < e2, isw_ = ti_ < e3p; const int j_ = ti_ - e3p; \
        const int ic_ = ti_ < e1 ? ti_ : ti_ - e1, iw_ = w0 + (ti_ < e2p ? 0 : (ti_ < e3 ? ti_ : e3 - 1) - e2p), is_ = j_ < nfp ? (j_ < nf ? j_ : nf - 1) : nf + (j_ - nfp); \
        const int idx_ = isc_ ? ic_ : isw_ ? iw_ : is_; const bf16* kb_s = isc_ ? kcseg : isw_ ? kwseg : ksseg; const bf16* vb_s = isc_ ? vcseg : isw_ ? vwseg : vsseg; \
        glds16s(kb_s + (size_t)idx_ * 4096, (unsigned)ksrc, (unsigned)__builtin_amdgcn_readfirstlane((int)(lds0 + (unsigned)((sbuf) + (b) * 16384) + wdst))); \
        glds16s(vb_s + (size_t)idx_ * 4096, (unsigned)vsrc, (unsigned)__builtin_amdgcn_readfirstlane((int)(lds0 + (unsigned)((sbuf) + (b) * 16384 + 8192) + wdst))); } while (0)
#pragma unroll
    for (int b = 0; b < NBS; ++b) NSA_STAGE(b, 0, b);
    float qq = 0.f;
#pragma unroll
    for (int s = 0; s < 4; ++s)
#pragma unroll
        for (int e = 0; e < 8; ++e) { const float v = bf2f((unsigned short)qf[s][e]); qq += v * v; }
    qq = half_sum(qq);
    const float kb_ = lut[131];
    const float lutfar = lut[r * LUTS + 129], mref = sqrtf(qq) * kb_ + lut[r * LUTS + 130];
    const int x7 = (c >> 1) & 7;
    const int kfo = c * 128;
    const int vsw = (lane >> 3) & 1;
    const int vfo = (4 * hi + ((lane & 15) >> 2)) * 128 + (16 * ((lane >> 4) & 1) + 4 * (lane & 3)) * 2 + vsw * 64;
    const int VD1 = 64 - 128 * vsw;
    f32x16 o0, o1;
#pragma unroll
    for (int i = 0; i < 16; ++i) { o0[i] = 0.f; o1[i] = 0.f; }
    float lsum = 0.f, linv_c = 0.f, carry = 0.f;
    asm volatile("s_waitcnt vmcnt(0) lgkmcnt(0)" ::: "memory");
    __syncthreads();
#define NSA_WINDOW_END() do { \
                const float gt2 = NSA_GATE(2); const float l = half_sum(lsum); const float sc = gt2 * (l > 0.f ? fast_rcp(l) : 0.f); \
                LAS unsigned* park = NSA_PARK; \
_Pragma("unroll") \
                for (int i = 0; i < 8; ++i) { const unsigned a_ = park[64 * i], b_ = park[64 * (8 + i)]; \
                    park[64 * i] = cvtpk(__uint_as_float(a_ << 16) + sc * o0[2 * i], __uint_as_float(a_ & 0xffff0000u) + sc * o0[2 * i + 1]); \
                    park[64 * (8 + i)] = cvtpk(__uint_as_float(b_ << 16) + sc * o1[2 * i], __uint_as_float(b_ & 0xffff0000u) + sc * o1[2 * i + 1]); } \
_Pragma("unroll") \
                for (int i = 0; i < 16; ++i) { o0[i] = 0.f; o1[i] = 0.f; } \
                lsum = 0.f; \
        } while (0)
    for (int st = 0; st < nstepsG; ++st) {
        const int sbuf = (st & 1) * NL_SBUF;
        if (st + 1 < nsteps) {
#pragma unroll
            for (int b = 0; b < NBS; ++b) NSA_STAGE((st + 1) * NBS + b, sbuf ^ NL_SBUF, b);
        }
#pragma unroll 1
        for (int b = 0; b < NBS; ++b) {
            const int ti = st * NBS + b;
            if (ti >= e3) break;
            if (ti >= e2 && ti < e2p) continue;
            const int mode = ti < e1 ? 0 : ti < e2 ? 1 : 3;
            int dbase, kstep, dmax; bool fast, colsel = true; int kind;
            if (mode < 2) { const int cc = mode == 0 ? ti : ti - e1; dbase = t - 16 * 64 * cc - 31; kstep = 16; dmax = 0x7fffffff; fast = (t0 - (16 * (64 * cc + 63) + 31)) >= 128; kind = fast ? 0 : 3; }
            else { const int ww = w0 + ti - e2p; dbase = t - 64 * ww; kstep = 1; dmax = WIN - 1; fast = (cur - ww) >= 3; kind = (cur - ww) <= 2 ? 1 : (cur - ww) <= 7 ? 0 : 2; }
            {
                const float cin = colsel ? (fast ? lutfar - mref : -mref) : -1e30f;
                f32x16 p0, p1;
#pragma unroll
                for (int i = 0; i < 16; ++i) { p0[i] = cin; p1[i] = cin; }
                NSA_READS(lds + sbuf + b * 16384 + kfo, lds + sbuf + b * 16384 + 8192 + vfo);
                NSA_QK();
                if (kind == 0) {
#pragma unroll
                    for (int i = 0; i < 16; ++i) { p0[i] = fast_exp2(p0[i]); p1[i] = fast_exp2(p1[i]); }
                } else if (kind == 1) NSA_SOFTMAX_NEAR(dbase);
                else if (kind == 2) NSA_SOFTMAX_FARMASK(dbase, dmax);
                else NSA_SOFTMAX_GENERAL(dbase);
                if (mode == 1) {
#pragma unroll
                    for (int i = 0; i < 16; ++i) { p0[i] *= linv_c; p1[i] *= linv_c; }
                    const int cc = ti - e1;
                    float A0[4], B0[4], A1[4], B1[4];
#pragma unroll
                    for (int q4 = 0; q4 < 4; ++q4) {
                        A0[q4] = p0[4 * q4] + p0[4 * q4 + 1] + p0[4 * q4 + 2] + 0.5f * p0[4 * q4 + 3]; B0[q4] = 0.5f * p0[4 * q4 + 3];
                        A1[q4] = p1[4 * q4] + p1[4 * q4 + 1] + p1[4 * q4 + 2] + 0.5f * p1[4 * q4 + 3]; B1[q4] = 0.5f * p1[4 * q4 + 3];
                        A0[q4] += dpp_x1(A0[q4]); A0[q4] += dpp_x2(A0[q4]); B0[q4] += dpp_x1(B0[q4]); B0[q4] += dpp_x2(B0[q4]);
                        A1[q4] += dpp_x1(A1[q4]); A1[q4] += dpp_x2(A1[q4]); B1[q4] += dpp_x1(B1[q4]); B1[q4] += dpp_x2(B1[q4]);
                    }
                    float Bl0[4], Bu0[4], Bl1[4], Bu1[4];
#pragma unroll
                    for (int q4 = 0; q4 < 4; ++q4) {
                        { auto rr = __builtin_amdgcn_permlane32_swap(__float_as_uint(B0[q4]), __float_as_uint(B0[q4]), false, false); Bl0[q4] = __uint_as_float(rr[0]); Bu0[q4] = __uint_as_float(rr[1]); }
                        { auto rr = __builtin_amdgcn_permlane32_swap(__float_as_uint(B1[q4]), __float_as_uint(B1[q4]), false, false); Bl1[q4] = __uint_as_float(rr[0]); Bu1[q4] = __uint_as_float(rr[1]); }
                    }
                    LAS float* irow = imp + tok * 132 + 16 * cc + hi;
#pragma unroll
                    for (int q4 = 0; q4 < 4; ++q4) {
                        const float s0 = hi ? Bl0[q4] : (q4 == 0 ? carry : Bu0[q4 - 1]);
                        const float s1 = hi ? Bl1[q4] : (q4 == 0 ? Bu0[3] : Bu1[q4 - 1]);
                        if (r == 0) { irow[2 * q4] = A0[q4] + s0; irow[8 + 2 * q4] = A1[q4] + s1; }
                    }
                    carry = Bu1[3];
                } else {
                    float s8[8];
#pragma unroll
                    for (int i = 0; i < 8; ++i) s8[i] = (p0[2 * i] + p0[2 * i + 1]) + (p1[2 * i] + p1[2 * i + 1]);
                    lsum += ((s8[0] + s8[1]) + (s8[2] + s8[3])) + ((s8[4] + s8[5]) + (s8[6] + s8[7]));
                }
                if (mode != 0) NSA_PV();
            }
            if (ti == e1 - 1) { const float l = half_sum(lsum); linv_c = l > 0.f ? fast_rcp(l) : 0.f; lsum = 0.f; carry = 0.f; }
            if (ti == e2 - 1) {
                asm volatile("s_waitcnt lgkmcnt(0)" ::: "memory");
                {
                    const int tk = lane >> 3, sub = lane & 7, j0 = sub * 16;
                    const LAS float* irow = imp + (8 * wave + tk) * 132 + j0;
                    unsigned s_[16];
#pragma unroll
                    for (int q = 0; q < 4; ++q) { const f32x4 v = *(const LAS f32x4*)(irow + 4 * q);
#pragma unroll
                        for (int e = 0; e < 4; ++e) { const int j = j0 + 4 * q + e; s_[4 * q + e] = (j >= 1 && j <= cur - 2) ? ((__float_as_uint(v[e]) & ~127u) | (unsigned)(127 - j)) : 0u; } }
#define CE(a_, b_) do { const unsigned hi_ = max(s_[a_], s_[b_]), lo_ = min(s_[a_], s_[b_]); s_[a_] = hi_; s_[b_] = lo_; } while (0)
                    CE(0, 1); CE(2, 3); CE(0, 2); CE(1, 3); CE(1, 2); CE(4, 5); CE(6, 7); CE(4, 6); CE(5, 7); CE(5, 6); CE(0, 4); CE(2, 6); CE(2, 4); CE(1, 5); CE(3, 7); CE(3, 5); CE(1, 2); CE(3, 4); CE(5, 6); CE(8, 9); CE(10, 11); CE(8, 10); CE(9, 11); CE(9, 10); CE(12, 13); CE(14, 15); CE(12, 14); CE(13, 15); CE(13, 14); CE(8, 12); CE(10, 14); CE(10, 12); CE(9, 13); CE(11, 15); CE(11, 13); CE(9, 10); CE(11, 12); CE(13, 14); CE(0, 8); CE(4, 12); CE(4, 8); CE(2, 10); CE(6, 14); CE(6, 10); CE(2, 4); CE(6, 8); CE(10, 12); CE(1, 9); CE(5, 13); CE(5, 9); CE(3, 11); CE(7, 15); CE(7, 11); CE(3, 5); CE(7, 9); CE(11, 13); CE(1, 2); CE(3, 4); CE(5, 6); CE(7, 8); CE(9, 10); CE(11, 12); CE(13, 14);
#undef CE
                    unsigned bits = 0u;
                    if (j0 == 0) bits |= 1u;
                    if ((cur >> 4) == sub) bits |= 1u << (cur & 15);
                    if (cur >= 1 && ((cur - 1) >> 4) == sub) bits |= 1u << ((cur - 1) & 15);
                    const int nforced = 1 + (cur >= 1 ? 1 : 0) + (cur >= 2 ? 1 : 0);
                    for (int it = nforced; it < NTOP; ++it) {
                        unsigned gm = s_[0];
                        gm = max(gm, (unsigned)__builtin_amdgcn_mov_dpp((int)gm, 0xB1, 0xf, 0xf, true));
                        gm = max(gm, (unsigned)__builtin_amdgcn_mov_dpp((int)gm, 0x4E, 0xf, 0xf, true));
                        gm = max(gm, (unsigned)__builtin_amdgcn_mov_dpp((int)gm, 0x141, 0xf, 0xf, true));
                        if (__ballot(gm != 0u) == 0ull) break;
                        const bool own = (s_[0] == gm) && gm != 0u;
                        bits |= own ? (1u << ((127u - (gm & 127u)) & 15u)) : 0u;
#pragma unroll
                        for (int i = 0; i < 15; ++i) s_[i] = own ? s_[i + 1] : s_[i];
                        s_[15] = own ? 0u : s_[15];
                    }
                    LAS unsigned short* sm16 = (LAS unsigned short*)(lds + NL_SELM);
                    sm16[(8 * wave + tk) * 8 + sub] = (unsigned short)bits;
                    asm volatile("s_waitcnt lgkmcnt(0)" ::: "memory");
                }
                { const float gt0 = NSA_GATE(0); LAS unsigned* park = NSA_PARK;
#pragma unroll
                  for (int i = 0; i < 8; ++i) { park[64 * i] = cvtpk(gt0 * o0[2 * i], gt0 * o0[2 * i + 1]); park[64 * (8 + i)] = cvtpk(gt0 * o1[2 * i], gt0 * o1[2 * i + 1]); }
#pragma unroll
                  for (int i = 0; i < 16; ++i) { o0[i] = 0.f; o1[i] = 0.f; } }
            }
            if (ti == e3 - 1) NSA_WINDOW_END();
        }
        asm volatile("s_waitcnt vmcnt(0) lgkmcnt(0)" ::: "memory");
        __syncthreads();
    }
    {
    const float mref_o = mref;
#define SBAR() __builtin_amdgcn_sched_barrier(0)
#define PIN(x) asm volatile("" : "+v"(x))
#define MFMA32(a, b, c) __builtin_amdgcn_mfma_f32_32x32x16_bf16(a, b, c, 0, 0, 0)
#define PKW(P, i) cvtpk_c(P[i], P[(i) + 1])
#define NB_KX(s) ((s) == 0 ? kx0 : (s) == 1 ? kx1 : (s) == 2 ? kx2 : kx3)
#define NB_KLD2(kk, s) do { const LAS unsigned char* kq_ = tb + (kk) * 16384 + kfo + NB_KX(s); kf[2 * (s)] = *(const LAS bf16x8_t*)(kq_); kf[2 * (s) + 1] = *(const LAS bf16x8_t*)(kq_ + 4096); } while (0)
#define NB_KRD(G, kk, s) do { if (G) { NB_KLD2(kk, s); SBAR(); } } while (0)
#define NB_VRD(j) do { vlo[j] = vtr(vq_ + ((j) >> 1) * 2048 + (((j) & 1) ? VD1 : 0)); vhi[j] = vtr(vq_ + ((j) >> 1) * 2048 + 1024 + (((j) & 1) ? VD1 : 0)); } while (0)
#define NB_VFR(j) (bf16x8_t){vlo[j][0], vlo[j][1], vlo[j][2], vlo[j][3], vhi[j][0], vhi[j][1], vhi[j][2], vhi[j][3]}
#define NB_PAF(k) __builtin_bit_cast(bf16x8_t, pw##k)
#define NB_GAPA(MF, a0, a1, a2, a3, D0, E0, D1, E1) do { MF; sacc += a0; sacc += a1; sacc += a2; sacc += a3; unsigned w0_ = E0, w1_ = E1; PIN(w0_); PIN(w1_); D0 = w0_; D1 = w1_; PIN(sacc); SBAR(); } while (0)
#define FIX0(x, i, H) (x)
#define FIXM(x, i, H) (((((i) & 3) + 8 * ((i) >> 2) + 32 * (H)) >= lo_) ? (x) : -1e30f)
#define FIX1(x, i, H) ((x) + rb_[32 * (H) + ((i) & 3) + 8 * ((i) >> 2)])
#define NB_GAPB(MF, X, i, H, FIX) do { MF; X[i] = fast_exp2(FIX(X[i], (i), H)); X[(i) + 1] = fast_exp2(FIX(X[(i) + 1], (i) + 1, H)); X[(i) + 2] = fast_exp2(FIX(X[(i) + 2], (i) + 2, H)); X[(i) + 3] = fast_exp2(FIX(X[(i) + 3], (i) + 3, H)); PIN(X); SBAR(); } while (0)
#define NB_GAPBP(OD, MF, X, i, H, FIX) do { MF; PIN(OD); X[i] = fast_exp2(FIX(X[i], (i), H)); X[(i) + 1] = fast_exp2(FIX(X[(i) + 1], (i) + 1, H)); X[(i) + 2] = fast_exp2(FIX(X[(i) + 2], (i) + 2, H)); X[(i) + 3] = fast_exp2(FIX(X[(i) + 3], (i) + 3, H)); PIN(X); SBAR(); } while (0)
#define NB_CIN(cval) f32x16 cinv; { float cin_ = (cval); asm volatile("" : "+v"(cin_));            \
        _Pragma("unroll") for (int i = 0; i < 16; ++i) cinv[i] = cin_; }
#define NB_HEAD(C0, C1, cval, kk, GL, knext, FIX) do { SBAR(); NB_KLD2(kk, 0); NB_KLD2(kk, 1); NB_KLD2(kk, 2); NB_KLD2(kk, 3); NB_CIN(cval); SBAR(); \
        C0 = MFMA32(kf[0], qf[0], cinv); C0 = MFMA32(kf[2], qf[1], C0); C0 = MFMA32(kf[4], qf[2], C0); C0 = MFMA32(kf[6], qf[3], C0); SBAR();            \
        C1 = MFMA32(kf[1], qf[0], cinv); SBAR(); \
        NB_GAPBP(C1, C1 = MFMA32(kf[3], qf[1], C1), C0, 0, 0, FIX); NB_GAPBP(C1, C1 = MFMA32(kf[5], qf[2], C1), C0, 4, 0, FIX); NB_GAPBP(C1, C1 = MFMA32(kf[7], qf[3], C1), C0, 8, 0, FIX); \
        if (GL) { NB_KLD2(knext, 0); NB_KLD2(knext, 1); NB_KLD2(knext, 2); NB_KLD2(knext, 3); SBAR(); } \
        NB_GAPB((void)0, C0, 12, 0, FIX); NB_GAPB((void)0, C1, 0, 1, FIX); NB_GAPB((void)0, C1, 4, 1, FIX); NB_GAPB((void)0, C1, 8, 1, FIX); NB_GAPB((void)0, C1, 12, 1, FIX); } while (0)
#define NB_STEP(C0, C1, cval, P0, P1, kprev, GL, knext, FIX) NB_STEPK(C0, C1, cval, P0, P1, kprev, GL, knext, FIX, false, 0)
#define NB_STEPK(C0, C1, cval, P0, P1, kprev, GL, knext, FIX, KL, kcur) do { SBAR(); if (KL) { NB_KLD2(kcur, 0); NB_KLD2(kcur, 1); NB_KLD2(kcur, 2); NB_KLD2(kcur, 3); SBAR(); }     \
        const LAS unsigned char* vq_ = tb + (kprev) * 16384 + 8192 + vfo; NB_CIN(cval); \
        float sacc = P0[0] + P0[1]; \
                           NB_GAPA(C0 = MFMA32(kf[0], qf[0], cinv), P0[2], P0[3], P0[4], P0[5],     pw0[0], PKW(P0, 0), pw0[1], PKW(P0, 2)); \
                           NB_GAPA(C1 = MFMA32(kf[1], qf[0], cinv), P0[6], P0[7], P0[8], P0[9],     pw0[2], PKW(P0, 4), pw0[3], PKW(P0, 6)); PIN(cinv); SBAR(); \
                           NB_GAPA(C0 = MFMA32(kf[2], qf[1], C0),   P0[10], P0[11], P0[12], P0[13], pw1[0], PKW(P0, 8), pw1[1], PKW(P0, 10)); \
                           NB_GAPA(C1 = MFMA32(kf[3], qf[1], C1),   P0[14], P0[15], P1[0], P1[1],   pw1[2], PKW(P0, 12), pw1[3], PKW(P0, 14)); \
        NB_VRD(0); SBAR(); NB_GAPA(C0 = MFMA32(kf[4], qf[2], C0),   P1[2], P1[3], P1[4], P1[5],     pw2[0], PKW(P1, 0), pw2[1], PKW(P1, 2)); \
        NB_VRD(1); SBAR(); NB_GAPA(C1 = MFMA32(kf[5], qf[2], C1),   P1[6], P1[7], P1[8], P1[9],     pw2[2], PKW(P1, 4), pw2[3], PKW(P1, 6)); \
        NB_VRD(2); SBAR(); NB_GAPA(C0 = MFMA32(kf[6], qf[3], C0),   P1[10], P1[11], P1[12], P1[13], pw3[0], PKW(P1, 8), pw3[1], PKW(P1, 10)); \
        NB_VRD(3); SBAR(); NB_GAPA(C1 = MFMA32(kf[7], qf[3], C1),   P1[14], P1[15], 0.f, 0.f,       pw3[2], PKW(P1, 12), pw3[3], PKW(P1, 14)); \
        lsum += sacc; SBAR(); \
        NB_VRD(4); SBAR(); NB_GAPBP(o0, o0 = MFMA32(NB_VFR(0), NB_PAF(0), o0), C0, 0, 0, FIX); \
        NB_VRD(5); SBAR(); NB_GAPBP(o1, o1 = MFMA32(NB_VFR(1), NB_PAF(0), o1), C0, 4, 0, FIX); \
        NB_VRD(6); SBAR(); NB_GAPBP(o0, o0 = MFMA32(NB_VFR(2), NB_PAF(1), o0), C0, 8, 0, FIX); \
        NB_VRD(7); SBAR(); NB_GAPBP(o1, o1 = MFMA32(NB_VFR(3), NB_PAF(1), o1), C0, 12, 0, FIX); \
        NB_KRD(GL, knext, 0); NB_GAPBP(o0, o0 = MFMA32(NB_VFR(4), NB_PAF(2), o0), C1, 0, 1, FIX); NB_KRD(GL, knext, 1); NB_GAPBP(o1, o1 = MFMA32(NB_VFR(5), NB_PAF(2), o1), C1, 4, 1, FIX); \
        NB_KRD(GL, knext, 2); NB_GAPBP(o0, o0 = MFMA32(NB_VFR(6), NB_PAF(3), o0), C1, 8, 1, FIX); NB_KRD(GL, knext, 3); NB_GAPBP(o1, o1 = MFMA32(NB_VFR(7), NB_PAF(3), o1), C1, 12, 1, FIX); \
        } while (0)
#define NB_TGAP(MF, a0, a1, a2, a3, a4, a5, a6, a7, D0, E0, D1, E1, D2, E2, D3, E3) do { MF; sacc += a0; sacc += a1; sacc += a2; sacc += a3; sacc += a4; sacc += a5; sacc += a6; sacc += a7; \
        unsigned w0_ = E0, w1_ = E1, w2_ = E2, w3_ = E3; PIN(w0_); PIN(w1_); PIN(w2_); PIN(w3_); D0 = w0_; D1 = w1_; D2 = w2_; D3 = w3_; PIN(sacc); SBAR(); } while (0)
#define NB_TAIL(P0, P1, kprev) do { SBAR(); const LAS unsigned char* vq_ = tb + (kprev) * 16384 + 8192 + vfo; \
        _Pragma("unroll") for (int j = 0; j < 8; ++j) NB_VRD(j); \
        float sacc = 0.f; \
        NB_TGAP((void)0, P0[0], P0[1], P0[2], P0[3], P0[4], P0[5], P0[6], P0[7], pw0[0], PKW(P0, 0), pw0[1], PKW(P0, 2), pw0[2], PKW(P0, 4), pw0[3], PKW(P0, 6)); \
        o0 = MFMA32(NB_VFR(0), NB_PAF(0), o0); \
        NB_TGAP(o1 = MFMA32(NB_VFR(1), NB_PAF(0), o1), P0[8], P0[9], P0[10], P0[11], P0[12], P0[13], P0[14], P0[15], pw1[0], PKW(P0, 8), pw1[1], PKW(P0, 10), pw1[2], PKW(P0, 12), pw1[3], PKW(P0, 14)); \
        o0 = MFMA32(NB_VFR(2), NB_PAF(1), o0); \
        NB_TGAP(o1 = MFMA32(NB_VFR(3), NB_PAF(1), o1), P1[0], P1[1], P1[2], P1[3], P1[4], P1[5], P1[6], P1[7], pw2[0], PKW(P1, 0), pw2[1], PKW(P1, 2), pw2[2], PKW(P1, 4), pw2[3], PKW(P1, 6)); \
        o0 = MFMA32(NB_VFR(4), NB_PAF(2), o0); \
        NB_TGAP(o1 = MFMA32(NB_VFR(5), NB_PAF(2), o1), P1[8], P1[9], P1[10], P1[11], P1[12], P1[13], P1[14], P1[15], pw3[0], PKW(P1, 8), pw3[1], PKW(P1, 10), pw3[2], PKW(P1, 12), pw3[3], PKW(P1, 14)); \
        o0 = MFMA32(NB_VFR(6), NB_PAF(3), o0); o1 = MFMA32(NB_VFR(7), NB_PAF(3), o1); lsum += sacc; SBAR(); } while (0)
#pragma unroll 1
    for (int st = nstepsG; st < nsteps; ++st) {
        f32x16 pA0, pA1, pB0, pB1; bf16x8_t kf[8]; v4i16_t vlo[8], vhi[8]; u32x4 pw0, pw1, pw2, pw3;
        const int lane = lane_fresh(), c = lane & 31, hi = lane >> 5, r = c & 3, tok = 8 * wave + (c >> 2), t = t0 + tok;
        const int x7 = (c >> 1) & 7, kfo = c * 128, vsw = (lane >> 3) & 1, vfo = (4 * hi + ((lane & 15) >> 2)) * 128 + (16 * ((lane >> 4) & 1) + 4 * (lane & 3)) * 2 + vsw * 64, VD1 = 64 - 128 * vsw;
        const int kx0 = ((0 + hi) ^ x7) << 4, kx1 = ((2 + hi) ^ x7) << 4, kx2 = ((4 + hi) ^ x7) << 4, kx3 = ((6 + hi) ^ x7) << 4;
        float mref = mref_o; asm volatile("" : "+v"(mref)); const float cfar = lut[r * LUTS + 129] - mref;
        if (st == nsteps - 1) {
    {
        const LAS unsigned char* tb = lds + ((nsteps - 1) & 1) * NL_SBUF;
        const LAS float* rlb = (const LAS float*)(lds + NL_RLUT) + r * RLS + 191 + 4 * hi;
        const LAS unsigned* swp = (const LAS unsigned*)(lds + NL_SELM + tok * 16);
#define NEAR_SETUP(b_) const int jj_ = (nf + (b_)) < cur ? (nf + (b_)) : cur; const bool cs_ = ((b_) < nn) && ((swp[jj_ >> 5] >> (jj_ & 31)) & 1u); \
        const LAS float* rb_ = rlb - (t - 64 * jj_); const float cv_ = cs_ ? -mref : -1e30f
        { NEAR_SETUP(0); NB_HEAD(pA0, pA1, cv_, 0, false, 0, FIX1); }
        { NEAR_SETUP(1); NB_STEPK(pB0, pB1, cv_, pA0, pA1, 0, false, 0, FIX1, true, 1); }
        { NEAR_SETUP(2); NB_STEPK(pA0, pA1, cv_, pB0, pB1, 1, false, 0, FIX1, true, 2); }
        NB_TAIL(pA0, pA1, 2);
#undef NEAR_SETUP
    }
            break;
        }
        if (st < nstepsA) {
            const int sbufw = (st & 1) * NL_SBUF;
#pragma unroll
            for (int b = 0; b < NBS; ++b) NSA_STAGE((st + 1) * NBS + b, sbufw ^ NL_SBUF, b);
            const LAS unsigned char* tb = lds + sbufw; const int sw = st - nstepsG; const int db0 = t - 64 * (w0 + 3 * sw);
            if (sw < 2) {
                { const int lo_ = db0 - (WIN - 1) - 4 * hi;       NB_HEAD(pA0, pA1, cfar, 0, false, 0, FIXM); }
                { const int lo_ = db0 - 64 - (WIN - 1) - 4 * hi;  NB_STEPK(pB0, pB1, cfar, pA0, pA1, 0, false, 0, FIXM, true, 1); }
                { const int lo_ = db0 - 128 - (WIN - 1) - 4 * hi; NB_STEPK(pA0, pA1, cfar, pB0, pB1, 1, false, 0, FIXM, true, 2); }
                NB_TAIL(pA0, pA1, 2);
            } else {
                const LAS float* rlb = (const LAS float*)(lds + NL_RLUT) + r * RLS + 191 + 4 * hi; const float cv_ = -mref;
                { const LAS float* rb_ = rlb - db0;         NB_HEAD(pA0, pA1, cv_, 0, false, 0, FIX1); }
                { const LAS float* rb_ = rlb - (db0 - 64);  NB_STEPK(pB0, pB1, cv_, pA0, pA1, 0, false, 0, FIX1, true, 1); }
                { const LAS float* rb_ = rlb - (db0 - 128); NB_STEPK(pA0, pA1, cv_, pB0, pB1, 1, false, 0, FIX1, true, 2); }
                NB_TAIL(pA0, pA1, 2);
                NSA_WINDOW_END();
            }
            asm volatile("s_waitcnt vmcnt(0) lgkmcnt(0)" ::: "memory");
            __syncthreads();
            continue;
        }
        const int sbuf = (st & 1) * NL_SBUF;
        const int j0 = (st - nstepsA) * NBS;
        const LAS unsigned* swp = (const LAS unsigned*)(lds + NL_SELM + tok * 16);
        const int wi = j0 >> 5; const unsigned wa_ = swp[wi], wb_ = swp[wi < 3 ? wi + 1 : 3];
        {
          const int jn = j0 + NBS; const bool nextnear = jn >= nfp;
#pragma unroll
          for (int b = 0; b < NBS; ++b) { int jj = nextnear ? nf + b : jn + b; const int jmax = nextnear ? cur : nf - 1; jj = jj < jmax ? jj : jmax;
              glds16s(ksseg + (size_t)jj * 4096, (unsigned)ksrc, (unsigned)__builtin_amdgcn_readfirstlane((int)(lds0 + (unsigned)((sbuf ^ NL_SBUF) + b * 16384) + wdst)));
              glds16s(vsseg + (size_t)jj * 4096, (unsigned)vsrc, (unsigned)__builtin_amdgcn_readfirstlane((int)(lds0 + (unsigned)((sbuf ^ NL_SBUF) + b * 16384 + 8192) + wdst))); } }
        const int bend = (nf - j0) < NBS ? (nf - j0) : NBS;
        {
            const unsigned sel3 = (unsigned)((((unsigned long long)wb_ << 32) | wa_) >> (j0 & 31));
            const bool cs0 = sel3 & 1u, cs1 = (1 < bend) && (sel3 & 2u), cs2 = (2 < bend) && (sel3 & 4u);
            const bool n0 = __ballot(cs0) != 0ull, n1 = __ballot(cs1) != 0ull, n2 = __ballot(cs2) != 0ull;
            const int cnt = (n0 ? 1 : 0) + (n1 ? 1 : 0) + (n2 ? 1 : 0);
            const int ka = n0 ? 0 : n1 ? 1 : 2, kb2 = (n0 && n1) ? 1 : 2;
            const bool csa = ka == 0 ? cs0 : ka == 1 ? cs1 : cs2, csb = kb2 == 1 ? cs1 : cs2, csc = cs2;
            const LAS unsigned char* tb = lds + sbuf;
            if (cnt == 1) { NB_HEAD(pA0, pA1, (csa ? cfar : -1e30f), ka, false, 0, FIX0); NB_TAIL(pA0, pA1, ka); }
            else if (cnt == 2) { NB_HEAD(pA0, pA1, (csa ? cfar : -1e30f), ka, true, kb2, FIX0); NB_STEP(pB0, pB1, (csb ? cfar : -1e30f), pA0, pA1, ka, false, 0, FIX0); NB_TAIL(pB0, pB1, kb2); }
            else if (cnt == 3) { NB_HEAD(pA0, pA1, (csa ? cfar : -1e30f), 0, true, 1, FIX0); NB_STEP(pB0, pB1, (csb ? cfar : -1e30f), pA0, pA1, 0, true, 2, FIX0); NB_STEP(pA0, pA1, (csc ? cfar : -1e30f), pB0, pB1, 1, false, 0, FIX0); NB_TAIL(pA0, pA1, 2); }
        }
        asm volatile("s_waitcnt vmcnt(0) lgkmcnt(0)" ::: "memory");
        __syncthreads();
    }
#undef NB_KX
#undef NB_KLD2
#undef NB_KRD
#undef NB_VRD
#undef NB_VFR
#undef NB_PAF
#undef NB_GAPA
#undef NB_GAPB
#undef NB_GAPBP
#undef NB_CIN
#undef NB_HEAD
#undef NB_STEP
#undef NB_STEPK
#undef NB_TAIL
#undef NB_TGAP
    }
#undef NSA_STAGE
#undef NSA_GATE
#undef NSA_WINDOW_END
#undef NSA_PARK
    { const int lane2 = lane_fresh(), wave2 = wave, c2 = lane2 & 31, hi2 = lane2 >> 5, r2 = c2 & 3;
      const size_t tl2 = (size_t)bl * SEQ + qb * 64 + 8 * wave2 + (c2 >> 2);
      const float gt1b = P.gates[tl2 * 48 + (g * 4 + r2) * 3 + 1];
      const float l = half_sum(lsum); const float sc = gt1b * (l > 0.f ? fast_rcp(l) : 0.f);
      const LAS unsigned* park = (const LAS unsigned*)(lds + NL_IMP) + wave2 * 1056 + lane2;
      bf16* orow = P.onsa + tl2 * DM + (g * 4 + r2) * 64; const int hi = hi2;
#pragma unroll
      for (int q4 = 0; q4 < 4; ++q4) {
          const unsigned a0 = park[64 * (2 * q4)], a1 = park[64 * (2 * q4 + 1)], b0 = park[64 * (8 + 2 * q4)], b1 = park[64 * (8 + 2 * q4 + 1)];
          u32x2 w0_; w0_.x = cvtpk(__uint_as_float(a0 << 16) + sc * o0[4 * q4], __uint_as_float(a0 & 0xffff0000u) + sc * o0[4 * q4 + 1]);
                     w0_.y = cvtpk(__uint_as_float(a1 << 16) + sc * o0[4 * q4 + 2], __uint_as_float(a1 & 0xffff0000u) + sc * o0[4 * q4 + 3]);
          u32x2 w1_; w1_.x = cvtpk(__uint_as_float(b0 << 16) + sc * o1[4 * q4], __uint_as_float(b0 & 0xffff0000u) + sc * o1[4 * q4 + 1]);
                     w1_.y = cvtpk(__uint_as_float(b1 << 16) + sc * o1[4 * q4 + 2], __uint_as_float(b1 & 0xffff0000u) + sc * o1[4 * q4 + 3]);
          *(u32x2*)(orow + 8 * q4 + 4 * hi) = w0_; *(u32x2*)(orow + 32 + 8 * q4 + 4 * hi) = w1_;
      } }
    asm volatile("s_waitcnt lgkmcnt(0)" ::: "memory");
    __syncthreads();
}
#undef NSA_READS
#undef NSA_VREADS01
#undef NSA_SOFTMAX_NEAR
#undef NSA_SOFTMAX_FARMASK
#undef NSA_QK
#undef NSA_PV
#undef NSA_SOFTMAX_GENERAL

constexpr int ML_A = 0, ML_ABUF = 32768, ML_B = 65536, ML_BBUF = 32768;
__device__ __forceinline__ void mem_unit_lds(const bf16* qm, const bf16* kmn, const bf16* vmt, bf16* omem, LAS unsigned char* lds, int tl0, int bglob, int hm, float mref, const int wave, const bool first, const bf16* kb_next, bf16x8_t (&qf)[16], const bf16* qm_next) {
    const int lane = lane_fresh(), tid = wave * 64 + lane, c = lane & 31, hi = lane >> 5;
    const unsigned lds0 = (unsigned)(uintptr_t)lds;
    { const bf16* qrow = qm + (size_t)(tl0 + 32 * wave + c) * DM + hm * MHD + 8 * hi;
#pragma unroll
      for (int s = 0; s < 16; ++s) qf[s] = *(const bf16x8_t*)(qrow + 16 * s); }
    const bf16* kb = kmn + (size_t)(bglob * MH + hm) * NMEM * MHD;
    const bf16* vb = vmt + (size_t)(bglob * MH + hm) * NMEM * MHD;
    int ksrc[4], vsrc[2];
#pragma unroll
    for (int i = 0; i < 4; ++i) { const int p = i * 512 + tid, row = p >> 5, ch = (p & 31) ^ (row & 15); ksrc[i] = (row * MHD + ch * 8) * 2; }
#pragma unroll
    for (int i = 0; i < 2; ++i) { const int p = i * 512 + tid, row = p >> 3, sl = (p & 7) ^ ((row >> 1) & 7); vsrc[i] = (row * NMEM + sl * 8) * 2; }
    const unsigned wdst = (unsigned)wave * 1024u;
#define MEM_DMA_K(kbase, mt, buf) do { _Pragma("unroll") for (int i_ = 0; i_ < 4; ++i_) \
        glds16((const char*)((kbase) + (size_t)(64 * (mt)) * MHD) + ksrc[i_], (unsigned)__builtin_amdgcn_readfirstlane((int)(lds0 + ML_A + (buf) * ML_ABUF + i_ * 8192 + wdst))); } while (0)
#define MEM_DMA_V(j, buf) do { _Pragma("unroll") for (int h_ = 0; h_ < 2; ++h_) { const int it_ = 2 * (j) + h_; _Pragma("unroll") for (int i_ = 0; i_ < 2; ++i_) \
        glds16((const char*)(vb + (size_t)(128 * (it_ >> 2)) * NMEM + 64 * (it_ & 3)) + vsrc[i_], (unsigned)__builtin_amdgcn_readfirstlane((int)(lds0 + ML_B + (buf) * ML_BBUF + h_ * 16384 + i_ * 8192 + wdst))); } } while (0)
    if (first) { MEM_DMA_K(kb, 0, 0); MEM_DMA_K(kb, 1, 1); }
    MEM_DMA_V(0, 0); MEM_DMA_V(1, 1);
    asm volatile("s_waitcnt vmcnt(8)" ::: "memory");
    float ss = 0.f;
#pragma unroll
    for (int s = 0; s < 16; ++s)
#pragma unroll
        for (int e = 0; e < 8; ++e) { const float v = bf2f((unsigned short)qf[s][e]); ss += v * v; }
    ss = half_sum(ss);
    const float f = rsqrtf(ss * (1.f / MHD) + EPS) * (LOG2E / 16.f);
    asm volatile("s_waitcnt lgkmcnt(0)" ::: "memory");
    __syncthreads();
    u32x4 pk[4][4]; float lsum = 0.f;
    const int kfo = c * 512, x15 = c & 15;
#pragma unroll
    for (int mt = 0; mt < 4; ++mt) {
        f32x16 p0, p1;
#pragma unroll
        for (int i = 0; i < 16; ++i) { p0[i] = 0.f; p1[i] = 0.f; }
        const LAS unsigned char* ka = lds + ML_A + (mt & 1) * ML_ABUF + kfo;
#pragma unroll
        for (int s = 0; s < 16; ++s) {
            const bf16x8_t a0 = *(const LAS bf16x8_t*)(ka + (((2 * s + hi) ^ x15) << 4)), a1 = *(const LAS bf16x8_t*)(ka + 32 * 512 + (((2 * s + hi) ^ x15) << 4));
            p0 = __builtin_amdgcn_mfma_f32_32x32x16_bf16(a0, qf[s], p0, 0, 0, 0);
            p1 = __builtin_amdgcn_mfma_f32_32x32x16_bf16(a1, qf[s], p1, 0, 0, 0);
            if ((s & 3) == 3) { __builtin_amdgcn_sched_group_barrier(0x100, 8, 0); __builtin_amdgcn_sched_group_barrier(0x008, 8, 0); __builtin_amdgcn_sched_barrier(0); }
        }
        float sm = 0.f;
#pragma unroll
        for (int i = 0; i < 16; ++i) { p0[i] = fast_exp2(p0[i] * f - mref); p1[i] = fast_exp2(p1[i] * f - mref); sm += p0[i] + p1[i]; }
        lsum += sm;
        pk[mt][0] = (u32x4){cvtpk(p0[0], p0[1]), cvtpk(p0[2], p0[3]), cvtpk(p0[4], p0[5]), cvtpk(p0[6], p0[7])};
        pk[mt][1] = (u32x4){cvtpk(p0[8], p0[9]), cvtpk(p0[10], p0[11]), cvtpk(p0[12], p0[13]), cvtpk(p0[14], p0[15])};
        pk[mt][2] = (u32x4){cvtpk(p1[0], p1[1]), cvtpk(p1[2], p1[3]), cvtpk(p1[4], p1[5]), cvtpk(p1[6], p1[7])};
        pk[mt][3] = (u32x4){cvtpk(p1[8], p1[9]), cvtpk(p1[10], p1[11]), cvtpk(p1[12], p1[13]), cvtpk(p1[14], p1[15])};
        asm volatile("s_waitcnt vmcnt(0) lgkmcnt(0)" ::: "memory");
        __syncthreads();
        if (mt < 2) MEM_DMA_K(kb, mt + 2, mt & 1);
    }
    if (kb_next != nullptr) { MEM_DMA_K(kb_next, 0, 0); MEM_DMA_K(kb_next, 1, 1);
        const bf16* qrn = qm_next + (size_t)(32 * wave + c) * DM + 8 * hi;
#pragma unroll
        for (int s = 0; s < 16; ++s) glds16((const char*)(qrn + 16 * s), (unsigned)__builtin_amdgcn_readfirstlane((int)(lds0 + ML_B + 2 * ML_BBUF + wdst))); }
    const float linv = fast_rcp(half_sum(lsum));
    bf16* orow = omem + (size_t)(tl0 + 32 * wave + c) * DM + hm * MHD + 4 * hi;
    const int vx = (c >> 1) & 7;
    f32x16 o[4];
#pragma unroll
    for (int it = 0; it < 8; ++it) {
        const int dh = it >> 2, mt = it & 3, j = it >> 1;
        if (mt == 0) {
#pragma unroll
            for (int dt = 0; dt < 4; ++dt)
#pragma unroll
                for (int i = 0; i < 16; ++i) o[dt][i] = 0.f;
        }
        const LAS unsigned char* va = lds + ML_B + (j & 1) * ML_BBUF + (it & 1) * 16384 + c * 128;
#pragma unroll
        for (int ks = 0; ks < 4; ++ks) {
            const bf16x8_t pb = __builtin_bit_cast(bf16x8_t, pk[mt][ks]);
#pragma unroll
            for (int dt = 0; dt < 4; ++dt) {
                const bf16x8_t vf = *(const LAS bf16x8_t*)(va + dt * 32 * 128 + (((2 * ks + hi) ^ vx) << 4));
                o[dt] = __builtin_amdgcn_mfma_f32_32x32x16_bf16(vf, pb, o[dt], 0, 0, 0);
            }
            __builtin_amdgcn_sched_group_barrier(0x100, 4, 0); __builtin_amdgcn_sched_group_barrier(0x008, 4, 0); __builtin_amdgcn_sched_barrier(0);
        }
        if (it & 1) asm volatile("s_waitcnt vmcnt(0)" ::: "memory");
        if (mt == 3) {
#pragma unroll
            for (int dt = 0; dt < 4; ++dt)
#pragma unroll
                for (int q4 = 0; q4 < 4; ++q4) {
                    u32x2 w; w.x = cvtpk(o[dt][4 * q4] * linv, o[dt][4 * q4 + 1] * linv); w.y = cvtpk(o[dt][4 * q4 + 2] * linv, o[dt][4 * q4 + 3] * linv);
                    *(u32x2*)(orow + 128 * dh + 32 * dt + 8 * q4) = w;
                }
        }
        if (it & 1) {
            asm volatile("s_waitcnt lgkmcnt(0)" ::: "memory");
            __syncthreads();
            if (j < 2) MEM_DMA_V(j + 2, j & 1);
        }
    }
#undef MEM_DMA_K
#undef MEM_DMA_V
}

#define ssq0 ((float*)(ws + OFF_SSQ0))
#define ssq1 ((float*)(ws + OFF_SSQ1))
#define ssq2 ((float*)(ws + OFF_SSQ2))
#define bias1 ((float*)(ws + OFF_BIAS1))
#define WC2T ((bf16*)(ws + OFF_WC2T))
#define W1T ((bf16*)(ws + WS_W1T))
#define W2T ((bf16*)(ws + WS_W2T))
#define WINT ((bf16*)(ws + WS_WINT))
#define WOT ((bf16*)(ws + WS_WOT))
#define W3T ((bf16*)(ws + WS_W3T))
#define W4T ((bf16*)(ws + WS_W4T))
#define WC1T ((bf16*)(ws + WS_WC1T))
#define WMKVT ((bf16*)(ws + WS_WMKVT))
#define MEMN ((bf16*)(ws + WS_MEMN))
#define KM ((bf16*)(ws + WS_KM))
#define VM ((bf16*)(ws + WS_VM))
#define KCMP ((bf16*)(ws + WS_KCMP))
#define HID ((bf16*)(ws + WS_HID))
#define ACT ((bf16*)(ws + WS_A))
#define MG ((unsigned char*)(ws + WS_MG))
#define GB ((bf16*)(ws + WS_GB))
#define UB ((bf16*)(ws + WS_U))
#define QM ((bf16*)out + (size_t)T * DM)
#define XB ((bf16*)(ws + WS_XB))
#define QN ((bf16*)out)
#define KV ((bf16*)(ws + WS_KV))
#define GATES ((float*)(ws + WS_GATES))
#define MERGED ((bf16*)(ws + WS_MERGED))
#define OMEM QM


typedef __attribute__((address_space(1))) unsigned gu32;
#define XB_TMO      128
#define XB_XCNT(j)  (256  + 64 * (j))
#define XB_XSUB(j)  (1280 + 64 * (j))
#define XB_XGEN(j)  (2304 + 64 * (j))
#define XB_TOP      3328
#define XB_TOPGEN   3392
#define XCD_BAR_WORDS 3456
#define XB_SPIN_CAP (1u << 18)

__device__ __forceinline__ unsigned xb_ld(unsigned* p)              { return __hip_atomic_load(p, __ATOMIC_RELAXED, __HIP_MEMORY_SCOPE_AGENT); }
__device__ __forceinline__ unsigned xb_add(unsigned* p, unsigned v) { return __hip_atomic_fetch_add(p, v, __ATOMIC_RELAXED, __HIP_MEMORY_SCOPE_AGENT); }
__device__ __forceinline__ unsigned xb_xcc_id() { return (unsigned)__builtin_amdgcn_s_getreg((3 << 11) | 20) & 0xFu; }
#define XB_SPIN(cond, bar) do { unsigned _sp = 0; while (cond) { __builtin_amdgcn_s_sleep(1); \
    if ((++_sp & 255u) == 0u) { if (xb_ld(&(bar)[XB_TMO])) break; if (_sp > XB_SPIN_CAP) { atomicAdd(&(bar)[XB_TMO], 1u); break; } } } } while (0)

struct XcdBarrier {
    unsigned* bar; unsigned x; int wv;
    volatile LAS unsigned* st;
};

__device__ __forceinline__ XcdBarrier xcd_barrier_post(unsigned* bar, volatile LAS unsigned* st, int wv) {
    XcdBarrier b; b.bar = bar; b.x = xb_xcc_id(); b.st = st; b.wv = wv;
    if (wv == 0 && lane_fresh() == 0) (void)xb_add(&bar[XB_XCNT(b.x)], 1u);
    return b;
}
__device__ __forceinline__ void xcd_barrier_complete(unsigned* bar, unsigned x, unsigned& nloc, unsigned& nx) {
    const unsigned G = gridDim.x * gridDim.y * gridDim.z;
    unsigned sum, cnt, mine, sp = 0u;
    for (;;) {
        sum = 0u; cnt = 0u; mine = 0u;
#pragma unroll
        for (unsigned j = 0; j < 16; ++j) { const unsigned c = xb_ld(&bar[XB_XCNT(j)]); sum += c; cnt += (c > 0u) ? 1u : 0u; mine = (j == x) ? c : mine; }
        if (sum == G) break;
        __builtin_amdgcn_s_sleep(1);
        if ((++sp & 255u) == 0u) { if (xb_ld(&bar[XB_TMO])) break; if (sp > XB_SPIN_CAP) { atomicAdd(&bar[XB_TMO], 1u); break; } }
    }
    nloc = mine > 0u ? mine : 1u; nx = cnt > 0u ? cnt : 1u;
}

__device__ __forceinline__ void xcd_barrier(const XcdBarrier& b) {
    asm volatile("s_waitcnt vmcnt(0)" ::: "memory");
    __syncthreads();
    if (b.wv == 0 && lane_fresh() == 0) {
        unsigned* bar = b.bar; unsigned bx_ = b.x;
        asm volatile("" : "+s"(bar), "+s"(bx_));
        __builtin_amdgcn_s_waitcnt(0);
        unsigned nloc = b.st[0], nx = b.st[1];
        if (nloc == 0u) { xcd_barrier_complete(bar, bx_, nloc, nx); b.st[0] = nloc; b.st[1] = nx; }
        const unsigned old = xb_add(&bar[XB_XSUB(bx_)], 1u);
        const unsigned gen = old / nloc;
        if (old + 1u == (gen + 1u) * nloc) {
            __builtin_amdgcn_fence(__ATOMIC_RELEASE, "agent");
            asm volatile("s_waitcnt vmcnt(0)" ::: "memory");
            const unsigned og = xb_add(&bar[XB_TOP], 1u);
            const unsigned tg = og / nx;
            if (og + 1u == (tg + 1u) * nx) xb_add(&bar[XB_TOPGEN], 1u);
            else XB_SPIN(xb_ld(&bar[XB_TOPGEN]) == tg, bar);
            __builtin_amdgcn_fence(__ATOMIC_ACQUIRE, "agent");
            xb_add(&bar[XB_XGEN(bx_)], 1u);
            asm volatile("s_waitcnt vmcnt(0)" ::: "memory");
        } else {
            XB_SPIN(xb_ld(&bar[XB_XGEN(bx_)]) == gen, bar);
            __builtin_amdgcn_fence(__ATOMIC_ACQUIRE, "agent");
            asm volatile("s_waitcnt vmcnt(0)" ::: "memory");
        }
    }
    __syncthreads();
}


__global__ void __launch_bounds__(512, 2) fwd_megakernel(Args args) {
    extern __shared__ __attribute__((aligned(16))) unsigned char lds_raw[];
    LAS unsigned char* lds = (LAS unsigned char*)lds_raw;
    const int wave = __builtin_amdgcn_readfirstlane((int)threadIdx.x >> 6);
    const int G = gridDim.x, bx = blockIdx.x;
    const int gw = bx * 8 + wave, NGW = G * 8;
    unsigned char* ws = args.ws;
    { volatile LAS unsigned* st = (volatile LAS unsigned*)(lds + LDS_BYTES - 64); const int t_ = wave * 64 + lane_fresh(); if (t_ < 8) st[t_] = 0u; }
    __syncthreads();
    const XcdBarrier bar = xcd_barrier_post((unsigned*)(ws + WS_CTL), (volatile LAS unsigned*)(lds + LDS_BYTES - 64), wave);
    const float* x = args.in[I_X]; float* out = args.out;

    {
        const int lane = lane_fresh();
        LAS float* scr = (LAS float*)(lds + wave * 16640);
        constexpr int I1 = (DM / 64) * (FF2 / 64), I2 = (FF / 64) * (DM / 64), I3 = (DM / 64) * (INWP / 64), I4 = (DM / 64) * (DM / 64);
        constexpr int I7 = (2048 / 64) * (256 / 64), I9 = (DM / 64) * (2048 / 64);
        constexpr int NITEMS = 2 * I1 + 2 * I2 + I3 + I4 + 2 * I7 + I9 + 8;
        for (int it = gw; it < NITEMS; it += NGW) {
            int r = it;
            if (r < I1) { transpose_item64<1>(args.in[I_F1WI], DM, FF2, args.in[I_F1G], W1T, scr, r, lane); continue; } r -= I1;
            if (r < I3) { transpose_item64<2>(args.in[I_WIN], DM, INW, args.in[I_MIXG], WINT, scr, r, lane); continue; } r -= I3;
            if (r < I1) { transpose_item64<1>(args.in[I_F2WI], DM, FF2, args.in[I_F2G], W3T, scr, r, lane); continue; } r -= I1;
            if (r < I2) { transpose_item64<0>(args.in[I_F1WO], FF, DM, nullptr, W2T, scr, r, lane); continue; } r -= I2;
            if (r < I2) { transpose_item64<0>(args.in[I_F2WO], FF, DM, nullptr, W4T, scr, r, lane); continue; } r -= I2;
            if (r < I4) { transpose_item64<0>(args.in[I_WOUT], DM, DM, nullptr, WOT, scr, r, lane); continue; } r -= I4;
            if (r < I7) { transpose_item64<0>(args.in[I_W1K], 2048, 256, nullptr, WC1T, scr, r, lane); continue; } r -= I7;
            if (r < I7) { transpose_item64<0>(args.in[I_W1V], 2048, 256, nullptr, WC1T + (size_t)256 * 2048, scr, r, lane); continue; } r -= I7;
            if (r < I9) { transpose_item64<0>(args.in[I_WMKV], DM, 2048, args.in[I_MEMG], WMKVT, scr, r, lane); continue; } r -= I9;
            if (r < 4) { transpose_item64<0>(args.in[I_W2K], 256, 64, nullptr, WC2T, scr, r, lane); continue; } r -= 4;
            transpose_item64<0>(args.in[I_W2V], 256, 64, nullptr, WC2T + 64 * 256, scr, r, lane);
        }
        for (int row = gw; row < T; row += 2 * NGW) {
            const int row2 = row + NGW;
            const bool has2 = row2 < T; const int rb = has2 ? row2 : row;
            const f32x4* xa = (const f32x4*)(x + (size_t)row * DM) + lane; const f32x4* xc = (const f32x4*)(x + (size_t)rb * DM) + lane;
            f32x4 va[4], vb[4];
#pragma unroll
            for (int j = 0; j < 4; ++j) { va[j] = xa[64 * j]; vb[j] = xc[64 * j]; }
            float sa = 0.f, sb = 0.f;
            u32x2* oa = (u32x2*)(XB + (size_t)row * DM) + lane; u32x2* ob = (u32x2*)(XB + (size_t)rb * DM) + lane;
#pragma unroll
            for (int j = 0; j < 4; ++j) {
                sa += va[j][0] * va[j][0] + va[j][1] * va[j][1] + va[j][2] * va[j][2] + va[j][3] * va[j][3];
                sb += vb[j][0] * vb[j][0] + vb[j][1] * vb[j][1] + vb[j][2] * vb[j][2] + vb[j][3] * vb[j][3];
                u32x2 w; w.x = pk2(va[j][0], va[j][1]); w.y = pk2(va[j][2], va[j][3]); oa[64 * j] = w;
                if (has2) { u32x2 w2; w2.x = pk2(vb[j][0], vb[j][1]); w2.y = pk2(vb[j][2], vb[j][3]); ob[64 * j] = w2; } }
            sa = wave_sum(sa); sb = wave_sum(sb);
            if (lane == 0) { ssq0[row] = sa; ssq1[row] = 0.f; ssq2[row] = 0.f; if (has2) { ssq0[row2] = sb; ssq1[row2] = 0.f; ssq2[row2] = 0.f; } }
        }
        for (int row = gw; row < NB * NMEM; row += NGW) {
            const f32x4* xr = (const f32x4*)(args.in[I_MEM] + (size_t)row * DM) + lane; f32x4 v[4]; float ss = 0.f;
#pragma unroll
            for (int j = 0; j < 4; ++j) { v[j] = xr[64 * j]; ss += v[j][0] * v[j][0] + v[j][1] * v[j][1] + v[j][2] * v[j][2] + v[j][3] * v[j][3]; }
            const float rs = rsqrtf(wave_sum(ss) * (1.f / DM) + EPS);
            u32x2* o8 = (u32x2*)(MEMN + (size_t)row * DM) + lane;
#pragma unroll
            for (int j = 0; j < 4; ++j) { u32x2 w; w.x = pk2(v[j][0] * rs, v[j][1] * rs); w.y = pk2(v[j][2] * rs, v[j][3] * rs); o8[64 * j] = w; }
        }
        for (int o = gw; o < 512; o += NGW) {
            const int kvsel = o >> 8, n = o & 255; const float* pe = args.in[kvsel ? I_PEV : I_PEK]; const float* w1 = args.in[kvsel ? I_W1V : I_W1K];
            float s = 0.f;
            for (int k = lane; k < 2048; k += 64) s += pe[k] * w1[(size_t)k * 256 + n];
            s = wave_sum(s); if (lane == 0) bias1[o] = s;
        }
    }
    xcd_barrier(bar);

    {
        pg8::Gemm g{XB, W1T, T, FF2, DM, DM}; pg8::StaticOrder S; S.init(T, FF2, G, bx);
        EpiSwiglu E{ACT, ssq0};
        pg8::gemm_phase<EpiSwiglu, pg8::StaticOrder, false, true>(lds, g, S, E, wave);
    }
    {
        pg8::Gemm g{MEMN, WMKVT, NB * NMEM, 2048, DM, DM}; pg8::StaticOrder S; S.init(NB * NMEM, 2048, G, bx);
        EpiMemKV E{KM, VM};
        pg8::gemm_phase<EpiMemKV, pg8::StaticOrder, false, true>(lds, g, S, E, wave);
    }
    xcd_barrier(bar);

    {
        const int lane_ = lane_fresh();
        for (int row = gw; row < NB * MH * NMEM; row += NGW) {
            bf16* kr = KM + (size_t)row * MHD + lane_ * 4; const u32x2 w = *(const u32x2*)kr;
            float k[4]; k[0] = __uint_as_float(w.x << 16); k[1] = __uint_as_float(w.x & 0xffff0000u); k[2] = __uint_as_float(w.y << 16); k[3] = __uint_as_float(w.y & 0xffff0000u);
            const float rs = rsqrtf(wave_sum(k[0] * k[0] + k[1] * k[1] + k[2] * k[2] + k[3] * k[3]) * (1.f / MHD) + EPS);
            const f32x4 gk = *(const f32x4*)(args.in[I_MKG] + lane_ * 4), gq = *(const f32x4*)(args.in[I_MQG] + lane_ * 4);
            u32x2 o; o.x = pk2(k[0] * rs * gk[0] * gq[0], k[1] * rs * gk[1] * gq[1]); o.y = pk2(k[2] * rs * gk[2] * gq[2], k[3] * rs * gk[3] * gq[3]);
            *(u32x2*)kr = o;
        }
        pg8::Gemm g{ACT, W2T, T, DM, FF, FF}; pg8::StaticOrder S; S.init(T, DM, G, bx);
        EpiResidB<false> E{XB, 0.5f, ssq1, nullptr};
        pg8::gemm_phase<EpiResidB<false>, pg8::StaticOrder, false, true>(lds, g, S, E, wave);
    }
    xcd_barrier(bar);

    for (int ch = 0; ch < NCHUNK; ++ch) {
        const int tok0 = ch * TC;
        {
            pg8::Gemm g{XB + (size_t)tok0 * DM, WINT, TC, INWP, DM, DM}; pg8::StaticOrder S; S.init(TC, INWP, G, bx);
            EpiMix E{ssq1 + tok0, args.in[I_QG], args.in[I_KG], QN, KV, GATES, UB, GB, QM, MG};
            pg8::gemm_phase<EpiMix, pg8::StaticOrder, false, true>(lds, g, S, E, wave);
        }
        xcd_barrier(bar);
        {
            constexpr int NU = 2 * BPC * NG * NCMPP / 256;
            pg8::Gemm g{KV, WC1T, NU * 256, 512, 2048, 1024}; pg8::PairOrder S{NU, NU / 2, G, bx};
            EpiHid E{HID, bias1};
            pg8::gemm_phase<EpiHid, pg8::PairOrder, false, true>(lds, g, S, E, wave);
            asm volatile("s_waitcnt vmcnt(0)" ::: "memory");
            __syncthreads();
            const int lane_ = lane_fresh();
            if (bx < NU) {
                const int kvsel = bx / (NU / 2); const int c = lane_ & 31, hi = lane_ >> 5; const int row = bx * 256 + wave * 32 + c;
                const bf16* hrow = HID + (size_t)row * 256 + 8 * hi; const bf16* wrow = WC2T + (size_t)kvsel * 64 * 256 + (size_t)c * 256 + 8 * hi;
                f32x16 a0, a1;
#pragma unroll
                for (int i = 0; i < 16; ++i) { a0[i] = 0.f; a1[i] = 0.f; }
                bf16x8_t hbv[16], w0v[16], w1v[16];
#pragma unroll
                for (int s2 = 0; s2 < 16; ++s2) { hbv[s2] = *(const bf16x8_t*)(hrow + 16 * s2); w0v[s2] = *(const bf16x8_t*)(wrow + 16 * s2); w1v[s2] = *(const bf16x8_t*)(wrow + 32 * 256 + 16 * s2); }
                __builtin_amdgcn_sched_barrier(0);
#pragma unroll
                for (int s2 = 0; s2 < 16; ++s2) {
                    a0 = __builtin_amdgcn_mfma_f32_32x32x16_bf16(w0v[s2], hbv[s2], a0, 0, 0, 0);
                    a1 = __builtin_amdgcn_mfma_f32_32x32x16_bf16(w1v[s2], hbv[s2], a1, 0, 0, 0);
                }
                if (kvsel == 0) {
                    float ss = 0.f;
#pragma unroll
                    for (int i = 0; i < 16; ++i) ss += a0[i] * a0[i] + a1[i] * a1[i];
                    const float rs = rsqrtf(half_sum(ss) * (1.f / 64.f) + EPS);
#pragma unroll
                    for (int i = 0; i < 16; ++i) { a0[i] *= rs * args.in[I_KG][crow(i, hi)]; a1[i] *= rs * args.in[I_KG][32 + crow(i, hi)]; }
                }
                const float keep = ((row & (NCMPP - 1)) == NCMP) ? 0.f : 1.f;
                bf16* orow = KCMP + (size_t)row * 64 + 4 * hi;
#pragma unroll
                for (int q4 = 0; q4 < 4; ++q4) {
                    u32x2 w0; w0.x = cvtpk(a0[4 * q4] * keep, a0[4 * q4 + 1] * keep); w0.y = cvtpk(a0[4 * q4 + 2] * keep, a0[4 * q4 + 3] * keep);
                    u32x2 w1; w1.x = cvtpk(a1[4 * q4] * keep, a1[4 * q4 + 1] * keep); w1.y = cvtpk(a1[4 * q4 + 2] * keep, a1[4 * q4 + 3] * keep);
                    *(u32x2*)(orow + 8 * q4) = w0; *(u32x2*)(orow + 32 + 8 * q4) = w1;
                }
            } else {
                float gmax = 0.f;
                { const f32x4 gk = *(const f32x4*)(args.in[I_MKG] + lane_ * 4), gq = *(const f32x4*)(args.in[I_MQG] + lane_ * 4);
                  gmax = wave_max(fmaxf(fmaxf(fabsf(gk[0] * gq[0]), fabsf(gk[1] * gq[1])), fmaxf(fabsf(gk[2] * gq[2]), fabsf(gk[3] * gq[3])))); }
                const float mrefm = 16.f * gmax * LOG2E * 1.02f;
                bf16x8_t qfm[16];
                for (int u = bx - NU; u < BPC * MH * (SEQ / 256); u += G - NU) { const int bl = u >> 7, hm = (u >> 5) & 3, tb = u & 31;
                    const int un = u + (G - NU); const bf16* kbn = (un < BPC * MH * (SEQ / 256)) ? KM + (size_t)((ch * BPC + (un >> 7)) * MH + ((un >> 5) & 3)) * NMEM * MHD : nullptr;
                    const bf16* qmn = (kbn != nullptr) ? QM + (size_t)((un >> 7) * SEQ + (un & 31) * 256) * DM + ((un >> 5) & 3) * MHD : nullptr;
                    mem_unit_lds(QM, KM, VM, OMEM, lds, bl * SEQ + tb * 256, ch * BPC + bl, hm, mrefm, wave, u == bx - NU, kbn, qfm, qmn); }
            }
        }
        xcd_barrier(bar);
        {
            NsaU U; U.qn = QN; U.kv = KV; U.kcmp = KCMP; U.gates = GATES; U.onsa = QN; U.relb = args.in[I_RELB]; U.kbound = 0.f;
            const int v = (G % 8 == 0) ? (bx % 8) * (G / 8) + bx / 8 : bx;
            for (int uu = v; uu < BPC * NG * 32; uu += G) {
                const int bg = uu >> 5, s5 = uu & 31;
                { LAS float* lut = (LAS float*)(lds + NL_LUT); const int g = bg & 3;
                  const int tid = wave * 64 + lane_fresh();
                  __syncthreads();
                  for (int i = tid; i < 4 * 129; i += 512) { const int rr = i / 129, n = i - rr * 129; lut[rr * LUTS + 1 + n] = args.in[I_RELB][rel_bucket(n) * NH + g * 4 + rr] * LOG2E; }
                  if (tid < 4) { float bm = -1e30f; for (int b_ = 0; b_ < 32; ++b_) bm = fmaxf(bm, args.in[I_RELB][b_ * NH + g * 4 + tid] * LOG2E); lut[tid * LUTS + 130] = bm; lut[tid * LUTS] = -1e30f;  }
                  if (tid < 64) { const float kmax_ = wave_max(fabsf(args.in[I_KG][tid])); if (tid == 0) lut[131] = 8.f * kmax_ * 1.01f; }
                  LAS float* rl = (LAS float*)(lds + NL_RLUT);
                  for (int i = tid; i < 4 * 256; i += 512) { const int rr = i >> 8, xx = i & 255, dist = 191 - xx;
                      rl[rr * RLS + xx] = dist < 0 ? -1e30f : args.in[I_RELB][rel_bucket(dist > 128 ? 128 : dist) * NH + g * 4 + rr] * LOG2E; }
                  __syncthreads(); }
#pragma unroll 1
                for (int k = 0; k < 4; ++k) { const int qb = (k == 0) ? s5 : (k == 1) ? 63 - s5 : (k == 2) ? 64 + s5 : 127 - s5;
                    nsa_unit(U, lds, bg >> 2, bg & 3, qb, wave); }
            }
        }
        xcd_barrier(bar);
        {
            const float* cw = args.in[I_CONVW]; const float* cb = args.in[I_CONVB];
            const int tid_ = wave * 64 + lane_fresh();
            for (size_t idx = (size_t)bx * 512 + tid_; idx < (size_t)TC * 128; idx += (size_t)G * 512) {
                const int tl = (int)(idx >> 7), c0 = (int)(idx & 127) * 8, s = tl & (SEQ - 1);
                float u0[8], u1[8], u2[8], gbv[8], gn[8], gc[8], gm[8], on[8], om[8];
                unpack8(*(const u32x4*)(UB + (size_t)tl * DM + c0), u2);
                if (s >= 1) unpack8(*(const u32x4*)(UB + (size_t)(tl - 1) * DM + c0), u1); else { for (int e = 0; e < 8; ++e) u1[e] = 0.f; }
                if (s >= 2) unpack8(*(const u32x4*)(UB + (size_t)(tl - 2) * DM + c0), u0); else { for (int e = 0; e < 8; ++e) u0[e] = 0.f; }
                unpack8(*(const u32x4*)(GB + (size_t)tl * DM + c0), gbv);
                { const u32x2 a8 = *(const u32x2*)(MG + (size_t)tl * 3072 + c0), b8 = *(const u32x2*)(MG + (size_t)tl * 3072 + 1024 + c0), c8 = *(const u32x2*)(MG + (size_t)tl * 3072 + 2048 + c0);
#pragma unroll
                  for (int e = 0; e < 4; ++e) { const float k255 = 1.f / 255.f;
                      gn[e] = (float)((a8.x >> (8 * e)) & 255u) * k255; gn[4 + e] = (float)((a8.y >> (8 * e)) & 255u) * k255;
                      gc[e] = (float)((b8.x >> (8 * e)) & 255u) * k255; gc[4 + e] = (float)((b8.y >> (8 * e)) & 255u) * k255;
                      gm[e] = (float)((c8.x >> (8 * e)) & 255u) * k255; gm[4 + e] = (float)((c8.y >> (8 * e)) & 255u) * k255; } }
                unpack8(*(const u32x4*)(QN + (size_t)tl * DM + c0), on);
                unpack8(*(const u32x4*)(OMEM + (size_t)tl * DM + c0), om);
                float o[8];
#pragma unroll
                for (int e = 0; e < 8; ++e) { const int c = c0 + e;
                    const float y = cw[c] * u0[e] + cw[DM + c] * u1[e] + cw[2 * DM + c] * u2[e] + cb[c];
                    o[e] = gn[e] * on[e] + gc[e] * (gbv[e] * y) + gm[e] * om[e]; }
                u32x4 w; w.x = pk2(o[0], o[1]); w.y = pk2(o[2], o[3]); w.z = pk2(o[4], o[5]); w.w = pk2(o[6], o[7]);
                *(u32x4*)(MERGED + (size_t)(tok0 + tl) * DM + c0) = w;
            }
        }
        xcd_barrier(bar);
    }

    {
        pg8::Gemm g{MERGED, WOT, T, DM, DM, DM}; pg8::StaticOrder S; S.init(T, DM, G, bx);
        EpiResidB<false> E{XB, 1.0f, ssq2, nullptr};
        pg8::gemm_phase<EpiResidB<false>, pg8::StaticOrder, false, true>(lds, g, S, E, wave);
    }
    xcd_barrier(bar);
    {
        pg8::Gemm g{XB, W3T, T, FF2, DM, DM}; pg8::StaticOrder S; S.init(T, FF2, G, bx);
        EpiSwiglu E{ACT, ssq2};
        pg8::gemm_phase<EpiSwiglu, pg8::StaticOrder, false, true>(lds, g, S, E, wave);
    }
    xcd_barrier(bar);
    {
        pg8::Gemm g{ACT, W4T, T, DM, FF, FF}; pg8::StaticOrder S; S.init(T, DM, G, bx);
        EpiResidB<true> E{XB, 0.5f, nullptr, out};
        pg8::gemm_phase<EpiResidB<true>, pg8::StaticOrder, false, true>(lds, g, S, E, wave);
    }
}

extern "C" void kernel_launch(void* const* d_in, const int* in_sizes, int n_in, void* d_out, int out_size, void* d_ws, size_t ws_size, hipStream_t stream) {
    static int grid = 0;
    if (grid == 0) {
        if (n_in != 26 || in_sizes[0] != T * DM || out_size != T * DM || ws_size < WS_END) {
            fprintf(stderr, "kernel_launch: unexpected shapes (n_in %d, in0 %d, out %d, ws %zu < %zu); nothing launched\n", n_in, n_in > 0 ? in_sizes[0] : -1, out_size, ws_size, (size_t)WS_END);
            grid = -1; return; }
        int dev = 0, cus = 0, per_cu = 0;
        (void)hipGetDevice(&dev); (void)hipDeviceGetAttribute(&cus, hipDeviceAttributeMultiprocessorCount, dev);
        (void)hipFuncSetAttribute((const void*)fwd_megakernel, hipFuncAttributeMaxDynamicSharedMemorySize, LDS_BYTES);
        (void)hipOccupancyMaxActiveBlocksPerMultiprocessor(&per_cu, (const void*)fwd_megakernel, 512, LDS_BYTES);
        if (per_cu < 1) { fprintf(stderr, "kernel_launch: occupancy query says %d blocks per CU\n", per_cu); per_cu = 1; }
        (void)hipGetLastError();
        grid = cus;
        if (grid != 256) fprintf(stderr, "kernel_launch: note: %d CUs\n", grid);
    }
    if (grid < 0) return;
    Args a{};
    for (int i = 0; i < 26; ++i) a.in[i] = (const float*)d_in[i];
    a.out = (float*)d_out; a.ws = (unsigned char*)d_ws;
    if (hipMemsetAsync((char*)d_ws + WS_CTL, 0, 16384, stream) != hipSuccess) { fprintf(stderr, "kernel_launch: hipMemsetAsync failed\n"); return; }
    hipLaunchKernelGGL(fwd_megakernel, dim3(grid), dim3(512), LDS_BYTES, stream, a);
    const hipError_t e = hipPeekAtLastError();
    if (e != hipSuccess) fprintf(stderr, "kernel_launch: launch failed: %s (grid %d)\n", hipGetErrorString(e), grid);
}
```

```cpp
#include <hip/hip_runtime.h>
#include <cstdio>
#include <cstdint>

__device__ __forceinline__ int lane_fresh() { int l; asm volatile("v_mbcnt_lo_u32_b32 %0, -1, 0\n\tv_mbcnt_hi_u32_b32 %0, -1, %0" : "=v"(l)); return l; }
namespace pg8 {
#define PG8_LAS __attribute__((address_space(3)))
typedef unsigned short bf16_t;
typedef short bf16x8 __attribute__((ext_vector_type(8)));
typedef float f32x4 __attribute__((ext_vector_type(4)));
typedef unsigned u32x4 __attribute__((ext_vector_type(4)));
typedef unsigned u32x2 __attribute__((ext_vector_type(2)));
constexpr int BM = 256, BK = 64, HALF = 128, HTB = HALF * BK * 2, STAGE_BYTES = 8 * HTB, NXCD = 8, WGM = 8;

__host__ __device__ __forceinline__ int lds_byte(int r, int c) { const int st = (r >> 4) * 2 + (c >> 5), rr = r & 15, cc = c & 31, ob = rr * 64 + cc * 2; return st * 1024 + (ob ^ (((ob >> 9) & 1) << 5)); }
__host__ __device__ __forceinline__ void stage_rc(int b, int& R, int& C) { const int st = b / 1024, sb = b % 1024, swz = sb ^ (((sb >> 9) & 1) << 5); R = (st >> 1) * 16 + swz / 64; C = (st & 1) * 32 + (swz % 64) / 2; }
__host__ __device__ __forceinline__ int perm32(int rho) { const int n = rho >> 4, i = rho & 15; return 8 * (i >> 2) + 4 * n + (i & 3); }

struct Unit { int pm, pn; };
struct Gemm { const bf16_t* A; const bf16_t* Bt; int M, N, K, lda; };

struct StaticOrder {
    int nM, nN, nwg, G, c;
    __host__ __device__ void init(int M, int N, int G_, int c_) { nM = M / BM; nN = N / BM; nwg = nM * nN; G = G_; c = c_; }
    __host__ __device__ bool next(int i, Unit& u) const {
        const long L = (long)i * G + c; if (L >= nwg) return false;
        int wgid = (int)L; { const int q = nwg / NXCD, r = nwg % NXCD, xcd = wgid % NXCD, off = wgid / NXCD; wgid = (xcd < r ? xcd * (q + 1) : r * (q + 1) + (xcd - r) * q) + off; }
        const int nig = WGM * nN, gid = wgid / nig, fm = gid * WGM, gsz = (nM - fm) < WGM ? (nM - fm) : WGM;
        u.pm = fm + ((wgid % nig) % gsz); u.pn = (wgid % nig) / gsz; return true;
    }
    __device__ __forceinline__ void a_ready(const Unit&) const {}
    __device__ __forceinline__ void done(const Unit&) const {}
};
struct PairOrder {
    int nu, per, G, c;
    __device__ bool next(int i, Unit& u) const { const int L = i * G + c; if (L >= nu) return false; u.pm = L; u.pn = L / per; return true; }
    __device__ __forceinline__ void a_ready(const Unit&) const {}
    __device__ __forceinline__ void done(const Unit&) const {}
};

__device__ __forceinline__ unsigned cvt_pk_bf16(float lo, float hi) { unsigned r; asm volatile("v_cvt_pk_bf16_f32 %0, %1, %2" : "=v"(r) : "v"(lo), "v"(hi)); return r; }

template <class Epi, class Sched, bool ALIGN_EPI = false, bool SP2 = false>
__device__ __forceinline__ void gemm_phase(PG8_LAS unsigned char* lds, const Gemm g, const Sched& S, const Epi& E, const int wv) {
    const int tid = wv * 64 + lane_fresh();
    const int wid = __builtin_amdgcn_readfirstlane(tid >> 6), lane = tid & 63, wr = wid >> 2, wc = wid & 3, fr = lane & 15, fq = lane >> 4;
    const int K = g.K, nt = K / BK;
    unsigned voffA[2], voffB[2];
#pragma unroll
    for (int i = 0; i < 2; ++i) { int R, C; stage_rc(tid * 16 + i * 8192, R, C); const int Rb = Epi::PERM ? ((R & ~31) + perm32(R & 31)) : R;
        voffA[i] = (unsigned)(R * g.lda + C) * 2u; voffB[i] = (unsigned)(Rb * K + C) * 2u; }
    const size_t kstep = (size_t)(BK * 2);
    const size_t hstepA = (size_t)HALF * g.lda * 2, hstepB = (size_t)HALF * K * 2;
    const size_t tstepA = 2 * hstepA, tstepB = 2 * hstepB;
    const unsigned ldsw = (unsigned)wid * 1024u;
    const int aoff = lds_byte(wr * 64 + fr, fq * 8), boff = lds_byte(wc * 32 + fr, fq * 8);
#define PG8_SA(b, h) (((b) * 2 + (h)) * HTB)
#define PG8_SB(b, h) ((4 + (b) * 2 + (h)) * HTB)
#define PG8_STAGE(bufoff, gbase, voff) do { _Pragma("unroll") for (int _i = 0; _i < 2; ++_i) \
        __builtin_amdgcn_global_load_lds((const unsigned*)((const char*)(gbase) + (voff)[_i]), (PG8_LAS unsigned*)(lds + (bufoff) + ldsw + _i * 8192), 16, 0, 0); } while (0)
#define PG8_LDA(dst, b, h) do { _Pragma("unroll") for (int m = 0; m < 4; ++m) _Pragma("unroll") for (int k = 0; k < 2; ++k) dst[m][k] = *(const PG8_LAS bf16x8*)(lds + PG8_SA(b, h) + aoff + m * 2048 + k * 1024); } while (0)
#define PG8_LDB(dst, b, h) do { _Pragma("unroll") for (int n = 0; n < 2; ++n) _Pragma("unroll") for (int k = 0; k < 2; ++k) dst[n][k] = *(const PG8_LAS bf16x8*)(lds + PG8_SB(b, h) + boff + n * 2048 + k * 1024); } while (0)
#define PG8_MMA(ai, bj, At, Bt) do { __builtin_amdgcn_s_setprio(1); _Pragma("unroll") for (int m = 0; m < 4; ++m) _Pragma("unroll") for (int n = 0; n < 2; ++n) _Pragma("unroll") for (int k = 0; k < 2; ++k) \
        acc[ai][bj][m][n] = __builtin_amdgcn_mfma_f32_16x16x32_bf16(Bt[n][k], At[m][k], acc[ai][bj][m][n], 0, 0, 0); __builtin_amdgcn_s_setprio(0); } while (0)
#define PG8_WAIT_V(n) asm volatile("s_waitcnt vmcnt(" #n ")" ::: "memory")
#define PG8_WAIT_L(n) asm volatile("s_waitcnt lgkmcnt(" #n ")" ::: "memory")
#define PG8_BAR __builtin_amdgcn_s_barrier()
#define PG8_SCHED __builtin_amdgcn_sched_barrier(0)
    Unit cur, nxt; int ui = 0;
    if (!S.next(0, cur)) return;
    f32x4 acc[2][2][4][2];
#pragma unroll
    for (int a = 0; a < 2; ++a)
#pragma unroll
        for (int b = 0; b < 2; ++b)
#pragma unroll
            for (int m = 0; m < 4; ++m)
#pragma unroll
                for (int n = 0; n < 2; ++n) acc[a][b][m][n] = (f32x4){0.f, 0.f, 0.f, 0.f};
    bf16x8 At[4][2], B0[2][2], B1[2][2];
    const char* cA = (const char*)g.A + (size_t)cur.pm * tstepA; const char* cB = (const char*)g.Bt + (size_t)cur.pn * tstepB;
    S.a_ready(cur);
    if constexpr (SP2) {
        PG8_STAGE(PG8_SB(0, 0), cB, voffB); PG8_STAGE(PG8_SB(0, 1), cB + hstepB, voffB); PG8_STAGE(PG8_SA(0, 0), cA, voffA); PG8_STAGE(PG8_SA(0, 1), cA + hstepA, voffA);
        if (wr == 1) PG8_BAR;
        PG8_WAIT_V(2); PG8_BAR;
        PG8_STAGE(PG8_SB(1, 0), cB + kstep, voffB); PG8_STAGE(PG8_SA(1, 0), cA + kstep, voffA); PG8_STAGE(PG8_SB(1, 1), cB + hstepB + kstep, voffB);
        PG8_WAIT_V(6); PG8_BAR;
    } else {
        PG8_STAGE(PG8_SB(0, 0), cB, voffB); PG8_STAGE(PG8_SA(0, 0), cA, voffA); PG8_STAGE(PG8_SB(0, 1), cB + hstepB, voffB); PG8_STAGE(PG8_SA(0, 1), cA + hstepA, voffA);
        if (wr == 1) PG8_BAR;
        PG8_WAIT_V(4); PG8_BAR;
        PG8_STAGE(PG8_SB(1, 0), cB + kstep, voffB); PG8_STAGE(PG8_SA(1, 0), cA + kstep, voffA); PG8_STAGE(PG8_SB(1, 1), cB + hstepB + kstep, voffB);
        PG8_WAIT_V(6); PG8_BAR;
    }
    for (;;) {
        const bool has_next = S.next(ui + 1, nxt);
        const char* nA = has_next ? (const char*)g.A + (size_t)nxt.pm * tstepA : cA; const char* nB = has_next ? (const char*)g.Bt + (size_t)nxt.pn * tstepB : cB;
        for (int t = 0; t < nt; t += 2) {
            const bool last = (t == nt - 2);
            const char* a1 = cA + (size_t)(t + 1) * kstep;
            const char* a2 = last ? nA : cA + (size_t)(t + 2) * kstep; const char* b2 = last ? nB : cB + (size_t)(t + 2) * kstep;
            const char* a3 = a2 + kstep; const char* b3 = b2 + kstep;
            if (last && has_next) S.a_ready(nxt);
            if constexpr (SP2) {
            PG8_LDB(B0, 0, 0); PG8_LDB(B1, 0, 1); PG8_SCHED; PG8_LDA(At, 0, 0); PG8_STAGE(PG8_SA(1, 1), a1 + hstepA, voffA);
            PG8_WAIT_V(8); PG8_WAIT_L(0); PG8_BAR; PG8_MMA(0, 0, At, B0); PG8_MMA(0, 1, At, B1); PG8_BAR; PG8_SCHED;
            PG8_LDA(At, 0, 1); PG8_STAGE(PG8_SB(0, 0), b2, voffB); PG8_STAGE(PG8_SB(0, 1), b2 + hstepB, voffB); PG8_STAGE(PG8_SA(0, 0), a2, voffA);
            PG8_WAIT_V(8); PG8_WAIT_L(0); PG8_BAR; PG8_MMA(1, 0, At, B0); PG8_MMA(1, 1, At, B1); PG8_BAR; PG8_SCHED;
            PG8_LDB(B0, 1, 0); PG8_LDB(B1, 1, 1); PG8_SCHED; PG8_LDA(At, 1, 0); PG8_STAGE(PG8_SA(0, 1), a2 + hstepA, voffA);
            PG8_WAIT_V(8); PG8_WAIT_L(0); PG8_BAR; PG8_MMA(0, 0, At, B0); PG8_MMA(0, 1, At, B1); PG8_BAR; PG8_SCHED;
            PG8_LDA(At, 1, 1); PG8_STAGE(PG8_SB(1, 0), b3, voffB); PG8_STAGE(PG8_SB(1, 1), b3 + hstepB, voffB); PG8_STAGE(PG8_SA(1, 0), a3, voffA);
            PG8_WAIT_V(8); PG8_WAIT_L(0); PG8_BAR; PG8_MMA(1, 0, At, B0); PG8_MMA(1, 1, At, B1); PG8_BAR; PG8_SCHED;
            } else {
            PG8_LDB(B0, 0, 0); PG8_SCHED; PG8_LDA(At, 0, 0); PG8_STAGE(PG8_SA(1, 1), a1 + hstepA, voffA);
            PG8_WAIT_L(8); PG8_BAR; PG8_WAIT_L(0); PG8_MMA(0, 0, At, B0); PG8_BAR; PG8_SCHED;
            PG8_LDB(B1, 0, 1); PG8_STAGE(PG8_SB(0, 0), b2, voffB);
            PG8_BAR; PG8_WAIT_L(0); PG8_MMA(0, 1, At, B1); PG8_BAR;
            PG8_LDA(At, 0, 1); PG8_STAGE(PG8_SA(0, 0), a2, voffA);
            PG8_BAR; PG8_WAIT_L(0); PG8_MMA(1, 0, At, B0); PG8_BAR; PG8_SCHED;
            PG8_STAGE(PG8_SB(0, 1), b2 + hstepB, voffB);
            PG8_WAIT_V(6); PG8_BAR; PG8_MMA(1, 1, At, B1); PG8_BAR;
            PG8_LDB(B0, 1, 0); PG8_SCHED; PG8_LDA(At, 1, 0); PG8_STAGE(PG8_SA(0, 1), a2 + hstepA, voffA);
            PG8_WAIT_L(8); PG8_BAR; PG8_WAIT_L(0); PG8_MMA(0, 0, At, B0); PG8_BAR; PG8_SCHED;
            PG8_LDB(B1, 1, 1); PG8_STAGE(PG8_SB(1, 0), b3, voffB);
            PG8_BAR; PG8_WAIT_L(0); PG8_MMA(0, 1, At, B1); PG8_BAR;
            PG8_LDA(At, 1, 1); PG8_STAGE(PG8_SA(1, 0), a3, voffA);
            PG8_BAR; PG8_WAIT_L(0); PG8_MMA(1, 0, At, B0); PG8_BAR; PG8_SCHED;
            PG8_STAGE(PG8_SB(1, 1), b3 + hstepB, voffB);
            PG8_WAIT_V(6); PG8_BAR; PG8_MMA(1, 1, At, B1); PG8_BAR;
            }
        }
        if constexpr (ALIGN_EPI) { if (wr == 0) PG8_BAR; }
        E(acc, cur, wr, wc, fr, fq); S.done(cur);
        if (!has_next) break;
#pragma unroll
        for (int a = 0; a < 2; ++a)
#pragma unroll
            for (int b = 0; b < 2; ++b)
#pragma unroll
                for (int m = 0; m < 4; ++m)
#pragma unroll
                    for (int n = 0; n < 2; ++n) acc[a][b][m][n] = (f32x4){0.f, 0.f, 0.f, 0.f};
        cur = nxt; cA = nA; cB = nB; ++ui;
        if constexpr (ALIGN_EPI) { if (wr == 1) PG8_BAR; }
    }
    PG8_WAIT_V(0);
    if constexpr (!ALIGN_EPI) { if (wr == 0) PG8_BAR; }
    PG8_BAR;
#undef PG8_SA
#undef PG8_SB
#undef PG8_STAGE
#undef PG8_LDA
#undef PG8_LDB
#undef PG8_MMA
#undef PG8_WAIT_V
#undef PG8_WAIT_L
#undef PG8_BAR
#undef PG8_SCHED
}
}

typedef unsigned short bf16;
typedef float f32x4 __attribute__((ext_vector_type(4)));
typedef unsigned u32x4 __attribute__((ext_vector_type(4)));
typedef unsigned u32x2 __attribute__((ext_vector_type(2)));
#define LAS __attribute__((address_space(3)))

constexpr int DM = 1024, NB = 4, SEQ = 8192, T = NB * SEQ;
constexpr int NH = 16, HD = 64, NG = 4, HPG = 4;
constexpr int NCMP = 511, NCMPP = 512;
constexpr int NSELB = 128, NTOP = 16, WIN = 512;
constexpr int NMEM = 256, MH = 4, MHD = 256;
constexpr int FF = 2816, FF2 = 5632;
constexpr int INW = 9776;
constexpr int NT_IN = 39, INWP = NT_IN * 256;
constexpr float EPS = 1e-6f;
constexpr float LOG2E = 1.4426950408889634f;
constexpr int NCHUNK = 1, TC = T / NCHUNK, BPC = NB / NCHUNK;
constexpr int C_Q = 0, C_KV = 1024, C_NG = 2560, C_GB = 2608, C_GC = 3632, C_XI = 4656, C_QM = 5680, C_MG = 6704;
constexpr int TQ0 = 0, TKV0 = 4, TNG = 10, TCU0 = 11, TGB0 = 19, TQM0 = 23, TMG0 = 27;

constexpr size_t MiB = 1u << 20;
constexpr size_t WS_CTL = 0;
constexpr size_t OFF_SSQ0 = 64 * 1024;
constexpr size_t OFF_SSQ1 = OFF_SSQ0 + (size_t)T * 4;
constexpr size_t OFF_SSQ2 = OFF_SSQ1 + (size_t)T * 4;
constexpr size_t OFF_BIAS1 = OFF_SSQ2 + (size_t)T * 4;
constexpr size_t OFF_WC2T = OFF_BIAS1 + 512 * 4;
constexpr size_t WS_SMALL_END = 1 * MiB;
static_assert(OFF_WC2T + 2 * 64 * 256 * 2 <= WS_SMALL_END, "small region");
constexpr size_t WS_W1T = 1 * MiB;
constexpr size_t WS_W2T = WS_W1T + (size_t)FF2 * DM * 2;
constexpr size_t WS_WINT = WS_W2T + (size_t)DM * FF * 2;
constexpr size_t WS_WOT = WS_WINT + (size_t)INWP * DM * 2;
constexpr size_t WS_W3T = WS_WOT + (size_t)DM * DM * 2;
constexpr size_t WS_W4T = WS_W3T + (size_t)FF2 * DM * 2;
constexpr size_t WS_WC1T = WS_W4T + (size_t)DM * FF * 2;
constexpr size_t WS_WMKVT = WS_WC1T + (size_t)512 * 2048 * 2;
constexpr size_t WS_MEMN = WS_WMKVT + (size_t)2048 * 1024 * 2;
constexpr size_t WS_KM = WS_MEMN + (size_t)1024 * 1024 * 2;
constexpr size_t WS_VM = WS_KM + (size_t)1024 * 1024 * 2;
constexpr size_t WS_KCMP = WS_VM + (size_t)1024 * 1024 * 2;
constexpr size_t WS_HID = WS_KCMP + (size_t)2 * BPC * NG * NCMPP * 64 * 2;
constexpr size_t WS_WEND = WS_HID + (size_t)2 * BPC * NG * NCMPP * 256 * 2;
static_assert(WS_WEND <= 84 * MiB, "weights region");
constexpr size_t WS_A = 84 * MiB;
constexpr size_t WS_MG = WS_A;
constexpr size_t WS_U = WS_MG + (size_t)TC * 3072;
constexpr size_t WS_GATES = WS_U + (size_t)TC * 1024 * 2;
static_assert(WS_GATES + (size_t)TC * 48 * 4 <= WS_A + 192 * MiB && (size_t)T * FF * 2 <= 192 * MiB, "region A");
constexpr size_t WS_XB = WS_A + 192 * MiB;
constexpr size_t WS_KV = WS_XB + 64 * MiB;
constexpr size_t KVSZ = (size_t)BPC * NG * SEQ * 64;
constexpr size_t WS_GB = WS_KV + 6 * KVSZ * 2 + 64 * 1024;
constexpr size_t WS_MERGED = WS_GB;
constexpr size_t WS_END = WS_GB + (size_t)T * 1024 * 2;
static_assert(WS_END <= 512 * MiB, "workspace map must fit 512 MiB");

constexpr int RING_BYTES = 131072;
constexpr int LDS_BYTES = 147456;

__device__ __forceinline__ float bf2f(unsigned short v) { return __uint_as_float((unsigned)v << 16); }
__device__ __forceinline__ unsigned f2bf(float f) { unsigned u = __float_as_uint(f); return (u + 0x7fffu + ((u >> 16) & 1u)) >> 16; }
typedef __bf16 bf16x2v_t __attribute__((ext_vector_type(2))); typedef float f32x2v_t __attribute__((ext_vector_type(2)));
__device__ __forceinline__ unsigned pk2(float lo, float hi) { return __builtin_bit_cast(unsigned, __builtin_convertvector((f32x2v_t){lo, hi}, bf16x2v_t)); }
template <int CTRL> __device__ __forceinline__ float dppf(float x) { return __builtin_bit_cast(float, __builtin_amdgcn_mov_dpp(__builtin_bit_cast(int, x), CTRL, 0xf, 0xf, true)); }
__device__ __forceinline__ float xor16f(float x) { return __builtin_bit_cast(float, __builtin_amdgcn_ds_swizzle(__builtin_bit_cast(int, x), 0x401F)); }
__device__ __forceinline__ float half_lo(float x, float& hi_) { auto rr = __builtin_amdgcn_permlane32_swap(__float_as_uint(x), __float_as_uint(x), false, false); hi_ = __uint_as_float(rr[1]); return __uint_as_float(rr[0]); }
__device__ __forceinline__ float wave_sum(float v) {
    v += dppf<0xB1>(v); v += dppf<0x4E>(v); v += dppf<0x141>(v); v += dppf<0x140>(v); v += xor16f(v);
    float h; const float l = half_lo(v, h); return l + h;
}
__device__ __forceinline__ float wave_max(float v) {
    v = fmaxf(v, dppf<0xB1>(v)); v = fmaxf(v, dppf<0x4E>(v)); v = fmaxf(v, dppf<0x141>(v)); v = fmaxf(v, dppf<0x140>(v)); v = fmaxf(v, xor16f(v));
    float h; const float l = half_lo(v, h); return fmaxf(l, h);
}
__device__ __forceinline__ float fast_exp2(float x) { return __builtin_amdgcn_exp2f(x); }
__device__ __forceinline__ float fast_rcp(float x) { return __builtin_amdgcn_rcpf(x); }
__device__ __forceinline__ float sigmoidf_(float v) { return fast_rcp(1.f + fast_exp2(-v * LOG2E)); }
__device__ __forceinline__ float siluf_(float v) { return v * sigmoidf_(v); }
__device__ __forceinline__ void unpack8(const u32x4 w, float* f) {
    f[0] = __uint_as_float(w.x << 16); f[1] = __uint_as_float(w.x & 0xffff0000u);
    f[2] = __uint_as_float(w.y << 16); f[3] = __uint_as_float(w.y & 0xffff0000u);
    f[4] = __uint_as_float(w.z << 16); f[5] = __uint_as_float(w.z & 0xffff0000u);
    f[6] = __uint_as_float(w.w << 16); f[7] = __uint_as_float(w.w & 0xffff0000u);
}

struct Args {
    const float* in[26];
    float* out;
    unsigned char* ws;
};
enum { I_X = 0, I_MEM, I_F1G, I_F1WI, I_F1WO, I_MIXG, I_WIN, I_QG, I_KG, I_PEK, I_W1K, I_W2K, I_PEV, I_W1V, I_W2V, I_CONVW, I_CONVB,
       I_MEMG, I_WMKV, I_MQG, I_MKG, I_WOUT, I_F2G, I_F2WI, I_F2WO, I_RELB };

__device__ __forceinline__ int src_swiglu(int n) { return ((n & 128) ? FF : 0) + 128 * (n >> 8) + (n & 127); }
__device__ __forceinline__ int src_win(int n) {
    const int pn = n >> 8, c = n & 255;
    if (pn < TKV0) return C_Q + 64 * (4 * pn + ((c >> 5) & 3)) + 32 * (c >> 7) + (c & 31);
    if (pn < TNG) return C_KV + 256 * (pn - TKV0) + 64 * ((c >> 5) & 3) + 32 * (c >> 7) + (c & 31);
    if (pn == TNG) return c < 48 ? C_NG + c : -1;
    if (pn < TGB0) return ((c & 128) ? C_XI : C_GC) + 128 * (pn - TCU0) + (c & 127);
    if (pn < TQM0) return C_GB + 256 * (pn - TGB0) + c;
    if (pn < TMG0) return C_QM + 256 * (pn - TQM0) + c;
    return C_MG + 256 * (pn - TMG0) + c;
}

template <int MAP>
__device__ __forceinline__ void transpose_item64(const float* W, int K, int N, const float* gk, bf16* WT, LAS float* scr, int item, int lane) {
    const int kblocks = K / 64, nb = item / kblocks, kb = item % kblocks, k0 = 64 * kb, n0 = 64 * nb;
    const int nq = (lane & 15) * 4, kr = lane >> 4, n = n0 + nq;
    const int src = (MAP == 0) ? n : (MAP == 1) ? src_swiglu(n) : src_win(n);
    f32x4 v[16];
#pragma unroll
    for (int i = 0; i < 16; ++i) { const int kk = 4 * i + kr; v[i] = (src >= 0) ? *(const f32x4*)(W + (size_t)(k0 + kk) * N + src) : (f32x4){0.f, 0.f, 0.f, 0.f}; }
#pragma unroll
    for (int i = 0; i < 16; ++i) { const int kk = 4 * i + kr; const float g = gk ? gk[k0 + kk] : 1.f;
        LAS float* d = scr + kk * 65 + nq; d[0] = v[i][0] * g; d[1] = v[i][1] * g; d[2] = v[i][2] * g; d[3] = v[i][3] * g; }
    asm volatile("s_waitcnt lgkmcnt(0)" ::: "memory");
    const int c = lane & 7;
#pragma unroll
    for (int j = 0; j < 8; ++j) { const int nn = (lane >> 3) + 8 * j; const LAS float* sp = scr + (8 * c) * 65 + nn;
        u32x4 o; o.x = pk2(sp[0 * 65], sp[1 * 65]); o.y = pk2(sp[2 * 65], sp[3 * 65]); o.z = pk2(sp[4 * 65], sp[5 * 65]); o.w = pk2(sp[6 * 65], sp[7 * 65]);
        *(u32x4*)(WT + (size_t)(n0 + nn) * K + k0 + 8 * c) = o; }
    asm volatile("s_waitcnt lgkmcnt(0)" ::: "memory");
}


struct EpiSwiglu {
    static constexpr bool PERM = true;
    bf16* act; const float* ssq;
    __device__ __forceinline__ void operator()(const f32x4 (&acc)[2][2][4][2], const pg8::Unit& u, int wr, int wc, int fr, int fq) const {
        float rsv[8];
#pragma unroll
        for (int i = 0; i < 8; ++i) rsv[i] = ssq[u.pm * 256 + (i >> 2) * 128 + wr * 64 + (i & 3) * 16 + fr];
#pragma unroll
        for (int ai = 0; ai < 2; ++ai)
#pragma unroll
            for (int m = 0; m < 4; ++m) {
                const int row = u.pm * 256 + ai * 128 + wr * 64 + m * 16 + fr;
                const float rs = rsqrtf(rsv[ai * 4 + m] * (1.f / DM) + EPS);
                float o[8];
#pragma unroll
                for (int n = 0; n < 2; ++n)
#pragma unroll
                    for (int e = 0; e < 4; ++e) { const float a = acc[ai][0][m][n][e] * rs, b = acc[ai][1][m][n][e] * rs; o[4 * n + e] = siluf_(a) * b; }
                u32x4 w; w.x = pk2(o[0], o[1]); w.y = pk2(o[2], o[3]); w.z = pk2(o[4], o[5]); w.w = pk2(o[6], o[7]);
                *(u32x4*)(act + (size_t)row * FF + u.pn * 128 + wc * 32 + fq * 8) = w;
            }
    }
};

template <bool LAST> struct EpiResidB {
    static constexpr bool PERM = true;
    bf16* xb; float alpha; float* ssq; float* out;
    __device__ __forceinline__ void operator()(const f32x4 (&acc)[2][2][4][2], const pg8::Unit& u, int wr, int wc, int fr, int fq) const {
        u32x4 bs[16];
#pragma unroll
        for (int i = 0; i < 16; ++i) { const int row = u.pm * 256 + (i >> 3) * 128 + wr * 64 + ((i >> 1) & 3) * 16 + fr;
            bs[i] = *(const u32x4*)(xb + (size_t)row * DM + u.pn * 256 + (i & 1) * 128 + wc * 32 + fq * 8); }
#pragma unroll
        for (int ai = 0; ai < 2; ++ai)
#pragma unroll
            for (int m = 0; m < 4; ++m) {
                const int row = u.pm * 256 + ai * 128 + wr * 64 + m * 16 + fr;
                float ss = 0.f;
#pragma unroll
                for (int bj = 0; bj < 2; ++bj) {
                    const size_t off = (size_t)row * DM + u.pn * 256 + bj * 128 + wc * 32 + fq * 8;
                    float b[8]; unpack8(bs[ai * 8 + m * 2 + bj], b);
                    float v[8];
#pragma unroll
                    for (int e = 0; e < 4; ++e) { v[e] = b[e] + alpha * acc[ai][bj][m][0][e]; v[4 + e] = b[4 + e] + alpha * acc[ai][bj][m][1][e]; }
                    if (LAST) { *(f32x4*)(out + off) = (f32x4){v[0], v[1], v[2], v[3]}; *(f32x4*)(out + off + 4) = (f32x4){v[4], v[5], v[6], v[7]}; }
                    else {
#pragma unroll
                        for (int e = 0; e < 8; ++e) ss += v[e] * v[e];
                        u32x4 w; w.x = pk2(v[0], v[1]); w.y = pk2(v[2], v[3]); w.z = pk2(v[4], v[5]); w.w = pk2(v[6], v[7]);
                        *(u32x4*)(xb + off) = w; }
                }
                if (!LAST) { ss += xor16f(ss); { float h_; const float l_ = half_lo(ss, h_); ss = l_ + h_; } if (fq == 0) atomicAdd(ssq + row, ss); }
            }
    }
};

struct EpiMemKV {
    static constexpr bool PERM = true;
    bf16* km; bf16* vm;
    __device__ __forceinline__ void operator()(const f32x4 (&acc)[2][2][4][2], const pg8::Unit& u, int wr, int wc, int fr, int fq) const {
        const int hm = u.pn & 3;
#pragma unroll
        for (int ai = 0; ai < 2; ++ai)
#pragma unroll
            for (int m = 0; m < 4; ++m) {
                const int row = u.pm * 256 + ai * 128 + wr * 64 + m * 16 + fr; const int b = row >> 8, mm = row & 255;
#pragma unroll
                for (int bj = 0; bj < 2; ++bj) {
                    const f32x4 v0 = acc[ai][bj][m][0], v1 = acc[ai][bj][m][1];
                    if (u.pn < 4) {
                        u32x4 w; w.x = pk2(v0[0], v0[1]); w.y = pk2(v0[2], v0[3]); w.z = pk2(v1[0], v1[1]); w.w = pk2(v1[2], v1[3]);
                        *(u32x4*)(km + ((size_t)(b * MH + hm) * NMEM + mm) * MHD + bj * 128 + wc * 32 + fq * 8) = w;
                    } else {
                        const int mp = (mm & ~12) | ((mm & 4) << 1) | ((mm & 8) >> 1);
                        bf16* vt = vm + ((size_t)(b * MH + hm) * MHD + bj * 128 + wc * 32 + fq * 8) * NMEM + mp;
#pragma unroll
                        for (int e = 0; e < 4; ++e) { vt[(size_t)e * NMEM] = (bf16)f2bf(v0[e]); vt[(size_t)(4 + e) * NMEM] = (bf16)f2bf(v1[e]); }
                    }
                }
            }
    }
};

struct EpiHid {
    static constexpr bool PERM = true;
    bf16* hid; const float* bias;
    __device__ __forceinline__ void operator()(const f32x4 (&acc)[2][2][4][2], const pg8::Unit& u, int wr, int wc, int fr, int fq) const {
#pragma unroll
        for (int bj = 0; bj < 2; ++bj) {
            const f32x4 b0 = *(const f32x4*)(bias + u.pn * 256 + bj * 128 + wc * 32 + fq * 8), b1 = *(const f32x4*)(bias + u.pn * 256 + bj * 128 + wc * 32 + fq * 8 + 4);
#pragma unroll
            for (int ai = 0; ai < 2; ++ai)
#pragma unroll
                for (int m = 0; m < 4; ++m) {
                    const int row = u.pm * 256 + ai * 128 + wr * 64 + m * 16 + fr;
                    float o[8];
#pragma unroll
                    for (int e = 0; e < 4; ++e) { o[e] = siluf_(acc[ai][bj][m][0][e] + b0[e]); o[4 + e] = siluf_(acc[ai][bj][m][1][e] + b1[e]); }
                    u32x4 w; w.x = pk2(o[0], o[1]); w.y = pk2(o[2], o[3]); w.z = pk2(o[4], o[5]); w.w = pk2(o[6], o[7]);
                    *(u32x4*)(hid + (size_t)row * 256 + bj * 128 + wc * 32 + fq * 8) = w;
                }
        }
    }
};

constexpr float QSCALE = 0.125f * LOG2E;

struct EpiMix {
    static constexpr bool PERM = true;
    const float* ssq;
    const float* qg; const float* kg;
    bf16* qn; bf16* kv; float* gates; bf16* u_; bf16* gb; bf16* qm; unsigned char* mg;
    __device__ __forceinline__ void operator()(const f32x4 (&acc)[2][2][4][2], const pg8::Unit& u, int wr, int wc, int fr, int fq) const {
        const int pn = u.pn;
        float gq[2][8];
        if (pn < TNG) {
            const float* gsrc = (pn < TKV0) ? qg : kg;
#pragma unroll
            for (int bj = 0; bj < 2; ++bj)
#pragma unroll
                for (int e = 0; e < 8; ++e) gq[bj][e] = gsrc[bj * 32 + fq * 8 + e];
        }
        float rsv[8];
#pragma unroll
        for (int i = 0; i < 8; ++i) rsv[i] = ssq[u.pm * 256 + (i >> 2) * 128 + wr * 64 + (i & 3) * 16 + fr];
#pragma unroll
        for (int ai = 0; ai < 2; ++ai)
#pragma unroll
            for (int m = 0; m < 4; ++m) {
                const int row = u.pm * 256 + ai * 128 + wr * 64 + m * 16 + fr;
                const float rs = rsqrtf(rsv[ai * 4 + m] * (1.f / DM) + EPS);
                float v[2][8];
#pragma unroll
                for (int bj = 0; bj < 2; ++bj)
#pragma unroll
                    for (int n = 0; n < 2; ++n)
#pragma unroll
                        for (int e = 0; e < 4; ++e) v[bj][4 * n + e] = acc[ai][bj][m][n][e] * rs;
                if (pn < TNG) {
                    const bool isq = pn < TKV0; const int kvi = pn - TKV0;
                    const bool donorm = isq || kvi == 2 || kvi == 4;
                    float ss = 0.f;
#pragma unroll
                    for (int bj = 0; bj < 2; ++bj)
#pragma unroll
                        for (int e = 0; e < 8; ++e) ss += v[bj][e] * v[bj][e];
                    ss += xor16f(ss); { float h_; const float l_ = half_lo(ss, h_); ss = l_ + h_; }
                    const float r2 = donorm ? rsqrtf(ss * (1.f / 64.f) + EPS) * (isq ? QSCALE : 1.f) : 1.f;
                    bf16* dst;
                    if (isq) dst = qn + (size_t)row * DM + (4 * pn + wc) * 64;
                    else { const int bl = row >> 13, s = row & (SEQ - 1); dst = kv + (size_t)kvi * KVSZ + ((size_t)(bl * NG + wc) * SEQ + s) * 64; }
#pragma unroll
                    for (int bj = 0; bj < 2; ++bj) {
                        float o[8];
#pragma unroll
                        for (int e = 0; e < 8; ++e) o[e] = donorm ? v[bj][e] * r2 * gq[bj][e] : v[bj][e];
                        u32x4 w; w.x = pk2(o[0], o[1]); w.y = pk2(o[2], o[3]); w.z = pk2(o[4], o[5]); w.w = pk2(o[6], o[7]);
                        *(u32x4*)(dst + bj * 32 + fq * 8) = w;
                    }
                } else if (pn == TNG) {
                    const int c0 = wc * 32 + fq * 8;
                    if (c0 < 48) {
                        f32x4 a, b;
#pragma unroll
                        for (int e = 0; e < 4; ++e) { a[e] = sigmoidf_(v[0][e]); b[e] = sigmoidf_(v[0][4 + e]); }
                        *(f32x4*)(gates + (size_t)row * 48 + c0) = a; *(f32x4*)(gates + (size_t)row * 48 + c0 + 4) = b;
                    }
                } else if (pn < TGB0) {
                    float o[8];
#pragma unroll
                    for (int e = 0; e < 8; ++e) o[e] = v[0][e] * v[1][e];
                    u32x4 w; w.x = pk2(o[0], o[1]); w.y = pk2(o[2], o[3]); w.z = pk2(o[4], o[5]); w.w = pk2(o[6], o[7]);
                    *(u32x4*)(u_ + (size_t)row * DM + (pn - TCU0) * 128 + wc * 32 + fq * 8) = w;
                } else {
                    if (pn < TMG0) {
                        bf16* dst = (pn < TQM0) ? gb + (size_t)row * DM + (pn - TGB0) * 256 : qm + (size_t)row * DM + (pn - TQM0) * 256;
#pragma unroll
                        for (int bj = 0; bj < 2; ++bj) {
                            u32x4 w; w.x = pk2(v[bj][0], v[bj][1]); w.y = pk2(v[bj][2], v[bj][3]); w.z = pk2(v[bj][4], v[bj][5]); w.w = pk2(v[bj][6], v[bj][7]);
                            *(u32x4*)(dst + bj * 128 + wc * 32 + fq * 8) = w;
                        }
                    } else {
                        unsigned char* dst = mg + (size_t)row * 3072 + (pn - TMG0) * 256;
#pragma unroll
                        for (int bj = 0; bj < 2; ++bj) {
                            unsigned q[8];
#pragma unroll
                            for (int e = 0; e < 8; ++e) q[e] = (unsigned)(sigmoidf_(v[bj][e]) * 255.f + 0.5f);
                            u32x2 w; w.x = q[0] | (q[1] << 8) | (q[2] << 16) | (q[3] << 24); w.y = q[4] | (q[5] << 8) | (q[6] << 16) | (q[7] << 24);
                            *(u32x2*)(dst + bj * 128 + wc * 32 + fq * 8) = w;
                        }
                    }
                }
            }
    }
};

__device__ __forceinline__ int rel_bucket(int n) {
    if (n < 16) return n < 0 ? 0 : n;
    if (n >= 128) return 31;
    const int b = 16 + (int)(__log2f((float)n * (1.f / 16.f)) * (16.f / 3.f));
    return b > 31 ? 31 : b;
}

typedef float f32x16 __attribute__((ext_vector_type(16)));
typedef short bf16x8_t __attribute__((ext_vector_type(8)));
typedef short v4i16_t __attribute__((ext_vector_type(4)));
typedef float f32x2_t __attribute__((ext_vector_type(2)));
typedef __bf16 bf16x2_t __attribute__((ext_vector_type(2)));
__device__ __forceinline__ unsigned cvtpk(float lo, float hi) { f32x2_t v = {lo, hi}; bf16x2_t b = __builtin_convertvector(v, bf16x2_t); return __builtin_bit_cast(unsigned, b); }
__device__ __forceinline__ int crow(int r, int hi) { return (r & 3) + 8 * (r >> 2) + 4 * hi; }
__device__ __forceinline__ unsigned cvtpk_c(float lo, float hi) { return __builtin_bit_cast(unsigned, __builtin_convertvector((f32x2v_t){lo, hi}, bf16x2v_t)); }
__device__ __forceinline__ float dpp_x1(float x) { return __builtin_bit_cast(float, __builtin_amdgcn_mov_dpp(__builtin_bit_cast(int, x), 0xB1, 0xf, 0xf, true)); }
__device__ __forceinline__ float dpp_x2(float x) { return __builtin_bit_cast(float, __builtin_amdgcn_mov_dpp(__builtin_bit_cast(int, x), 0x4E, 0xf, 0xf, true)); }
__device__ __forceinline__ float half_sum(float x) { auto rr = __builtin_amdgcn_permlane32_swap(__float_as_uint(x), __float_as_uint(x), false, false); return __uint_as_float(rr[0]) + __uint_as_float(rr[1]); }
__device__ __forceinline__ v4i16_t vtr(const LAS unsigned char* p) { return __builtin_amdgcn_ds_read_tr16_b64_v4i16((LAS v4i16_t*)p); }

__device__ __forceinline__ void glds16(const void* gsrc, unsigned lds_dst) { unsigned keep;
    asm volatile("s_mov_b32 %0, m0\n\ts_mov_b32 m0, %2\n\ts_nop 0\n\tglobal_load_lds_dwordx4 %1, off\n\ts_mov_b32 m0, %0" : "=&s"(keep) : "v"(gsrc), "s"(lds_dst) : "memory"); }
__device__ __forceinline__ void glds16s(const void* sbase, unsigned voff, unsigned lds_dst) { unsigned keep;
    asm volatile("s_mov_b32 %0, m0\n\ts_mov_b32 m0, %2\n\ts_nop 0\n\tglobal_load_lds_dwordx4 %1, %3\n\ts_mov_b32 m0, %0" : "=&s"(keep) : "v"(voff), "s"(lds_dst), "s"(sbase) : "memory"); }
constexpr int NBS = 3;
constexpr int NL_SBUF = NBS * 16384;
constexpr int LUTS = 136, RLS = 264;
constexpr int NL_IMP = 2 * NL_SBUF, NL_LUT = NL_IMP + 64 * 132 * 4, NL_SELM = NL_LUT + 4 * LUTS * 4, NL_RLUT = NL_SELM + 64 * 16, NL_END = NL_RLUT + 4 * RLS * 4;
static_assert(NL_END <= LDS_BYTES - 64, "NSA LDS map");

struct NsaU { const bf16* qn; const bf16* kv; const bf16* kcmp; const float* gates; bf16* onsa; const float* relb; float kbound; };

#define NSA_READS(kbase, vbase) v4i16_t vr_[8]; const LAS unsigned char* kb_ = (kbase); const LAS unsigned char* vb_ = (vbase)
#define NSA_VREADS01() do { _Pragma("unroll") for (int ks = 0; ks < 2; ++ks) { vr_[4 * ks] = vtr(vb_ + ks * 2048); vr_[4 * ks + 1] = vtr(vb_ + ks * 2048 + 1024); vr_[4 * ks + 2] = vtr(vb_ + ks * 2048 + VD1); vr_[4 * ks + 3] = vtr(vb_ + ks * 2048 + 1024 + VD1); } \
        } while (0)
#define NSA_QK() do { bf16x8_t ka_[8]; _Pragma("unroll") for (int s = 0; s < 4; ++s) { \
        ka_[2 * s] = *(const LAS bf16x8_t*)(kb_ + (((2 * s + hi) ^ x7) << 4)); ka_[2 * s + 1] = *(const LAS bf16x8_t*)(kb_ + 4096 + (((2 * s + hi) ^ x7) << 4)); } \
        NSA_VREADS01(); _Pragma("unroll") for (int s = 0; s < 4; ++s) { \
        p0 = __builtin_amdgcn_mfma_f32_32x32x16_bf16(ka_[2 * s], qf[s], p0, 0, 0, 0); p1 = __builtin_amdgcn_mfma_f32_32x32x16_bf16(ka_[2 * s + 1], qf[s], p1, 0, 0, 0); } \
        __builtin_amdgcn_sched_group_barrier(0x100, 16, 0); __builtin_amdgcn_sched_group_barrier(0x008, 8, 0); \
        __builtin_amdgcn_sched_barrier(0); } while (0)
#define NSA_PV() do { u32x4 pk[4]; v4i16_t vs_[8]; \
        _Pragma("unroll") for (int ks = 2; ks < 4; ++ks) { vs_[4 * ks - 8] = vtr(vb_ + ks * 2048); vs_[4 * ks - 7] = vtr(vb_ + ks * 2048 + 1024); vs_[4 * ks - 6] = vtr(vb_ + ks * 2048 + VD1); vs_[4 * ks - 5] = vtr(vb_ + ks * 2048 + 1024 + VD1); } \
        pk[0] = (u32x4){cvtpk(p0[0], p0[1]), cvtpk(p0[2], p0[3]), cvtpk(p0[4], p0[5]), cvtpk(p0[6], p0[7])}; \
        pk[1] = (u32x4){cvtpk(p0[8], p0[9]), cvtpk(p0[10], p0[11]), cvtpk(p0[12], p0[13]), cvtpk(p0[14], p0[15])}; \
        pk[2] = (u32x4){cvtpk(p1[0], p1[1]), cvtpk(p1[2], p1[3]), cvtpk(p1[4], p1[5]), cvtpk(p1[6], p1[7])}; \
        pk[3] = (u32x4){cvtpk(p1[8], p1[9]), cvtpk(p1[10], p1[11]), cvtpk(p1[12], p1[13]), cvtpk(p1[14], p1[15])}; \
        _Pragma("unroll") for (int ks = 0; ks < 4; ++ks) { \
            const v4i16_t l0 = ks < 2 ? vr_[4 * ks] : vs_[4 * ks - 8], h0 = ks < 2 ? vr_[4 * ks + 1] : vs_[4 * ks - 7], l1 = ks < 2 ? vr_[4 * ks + 2] : vs_[4 * ks - 6], h1 = ks < 2 ? vr_[4 * ks + 3] : vs_[4 * ks - 5]; \
            const bf16x8_t vf0 = (bf16x8_t){l0[0], l0[1], l0[2], l0[3], h0[0], h0[1], h0[2], h0[3]}; \
            const bf16x8_t vf1 = (bf16x8_t){l1[0], l1[1], l1[2], l1[3], h1[0], h1[1], h1[2], h1[3]}; \
            const bf16x8_t pb = __builtin_bit_cast(bf16x8_t, pk[ks]); \
            o0 = __builtin_amdgcn_mfma_f32_32x32x16_bf16(vf0, pb, o0, 0, 0, 0); o1 = __builtin_amdgcn_mfma_f32_32x32x16_bf16(vf1, pb, o1, 0, 0, 0); } } while (0)
#define NSA_SOFTMAX_GENERAL(dbase_) do { const LAS float* lutr = lut + r * LUTS; const int a_ = (dbase_) - 64 * hi + 1; _Pragma("unroll") for (int i = 0; i < 16; ++i) { \
        const int c_ = 16 * ((i & 3) + 8 * (i >> 2)); int i0 = a_ - c_, i1 = a_ - c_ - 512; i0 = i0 < 0 ? 0 : (i0 > 129 ? 129 : i0); i1 = i1 < 0 ? 0 : (i1 > 129 ? 129 : i1); \
        p0[i] = fast_exp2(p0[i] + lutr[i0]); p1[i] = fast_exp2(p1[i] + lutr[i1]); } } while (0)

#define NSA_SOFTMAX_NEAR(dbase_) do { const LAS float* rb_ = (const LAS float*)(lds + NL_RLUT) + r * RLS + (191 - (dbase_) + 4 * hi); _Pragma("unroll") for (int i = 0; i < 16; ++i) { \
        p0[i] = fast_exp2(p0[i] + rb_[(i & 3) + 8 * (i >> 2)]); p1[i] = fast_exp2(p1[i] + rb_[32 + (i & 3) + 8 * (i >> 2)]); } } while (0)
#define NSA_SOFTMAX_FARMASK(dbase_, dmax_) do { const int lo_ = (dbase_) - (dmax_) - 4 * hi; _Pragma("unroll") for (int i = 0; i < 16; ++i) { \
        const int k0 = (i & 3) + 8 * (i >> 2); p0[i] = fast_exp2(k0 >= lo_ ? p0[i] : -1e30f); p1[i] = fast_exp2(k0 + 32 >= lo_ ? p1[i] : -1e30f); } } while (0)
__device__ __forceinline__ void nsa_unit(const NsaU& P, LAS unsigned char* lds_in, int bl, int g, int qb, const int wave_in) {
    int wave = wave_in; unsigned ldsu = (unsigned)(uintptr_t)lds_in; asm volatile("" : "+s"(wave), "+s"(ldsu));
    LAS unsigned char* lds = (LAS unsigned char*)(uintptr_t)ldsu;
    const int lane = lane_fresh(), tid = wave * 64 + lane, c = lane & 31, hi = lane >> 5;
    const int tok = 8 * wave + (c >> 2), r = c & 3, t0 = qb * 64, t = t0 + tok, cur = qb;
    const size_t tl = (size_t)bl * SEQ + t;
    LAS float* imp = (LAS float*)(lds + NL_IMP); LAS float* lut = (LAS float*)(lds + NL_LUT);
    const unsigned lds0 = (unsigned)(uintptr_t)lds;
    bf16x8_t qf[4];
    { const bf16* qrow = P.qn + tl * DM + (g * 4 + r) * 64;
#pragma unroll
      for (int s = 0; s < 4; ++s) qf[s] = *(const bf16x8_t*)(qrow + 16 * s + 8 * hi); }
    const size_t segkv = (size_t)(bl * NG + g) * SEQ * 64;
    const bf16* kcseg = P.kcmp + (size_t)(bl * NG + g) * NCMPP * 64; const bf16* vcseg = kcseg + (size_t)BPC * NG * NCMPP * 64;
    const bf16* ksseg = P.kv + 2 * KVSZ + segkv; const bf16* vsseg = P.kv + 3 * KVSZ + segkv;
    const bf16* kwseg = P.kv + 4 * KVSZ + segkv; const bf16* vwseg = P.kv + 5 * KVSZ + segkv;
    const int nc = (4 * cur + 2) / 64 + 1, w0 = cur > 8 ? cur - 8 : 0, nw = cur - w0 + 1;
    const int e1 = nc, e2 = 2 * nc, e2p = ((e2 + NBS - 1) / NBS) * NBS, e3 = e2p + nw, e3p = ((e3 + NBS - 1) / NBS) * NBS, nstepsA = e3p / NBS;
    const bool wpipe = cur >= 8;
    const int nstepsG = wpipe ? e2p / NBS : nstepsA;
    const int nf = cur > 2 ? cur - 2 : 0, nfp = ((nf + NBS - 1) / NBS) * NBS, nn = cur + 1 - nf, NT = e3p + nfp + nn, nsteps = nstepsA + nfp / NBS + 1;
    const int srow = tid >> 3, sch = tid & 7;
    const int ksrc = srow * 128 + ((sch ^ ((srow >> 1) & 7)) << 4), vsrc = srow * 128 + ((sch ^ (((srow >> 1) & 1) << 2)) << 4);
    const unsigned wdst = (unsigned)wave * 1024u;
#define NSA_GATE(k_) ([&]() { const int c_ = lane_fresh() & 31; \
        return P.gates[((size_t)bl * SEQ + qb * 64 + 8 * wave + (c_ >> 2)) * 48 + (g * 4 + (c_ & 3)) * 3 + (k_)]; }())
#define NSA_PARK ((LAS unsigned*)(lds + NL_IMP) + wave * 1056 + lane)
#define NSA_STAGE(ti, sbuf, b) do { int ti_ = (ti); ti_ = ti_ < NT ? ti_ : NT - 1;              \
        const bool isc_ = ti_ < e2, isw_ = ti_ < e3p; const int j_ = ti_ - e3p; \
        const int ic_ = ti_ < e1 ? ti_ : ti_ - e1, iw_ = w0 + (ti_ < e2p ? 0 : (ti_ < e3 ? ti_ : e3 - 1) - e2p), is_ = j_ < nfp ? (j_ < nf ? j_ : nf - 1) : nf + (j_ - nfp); \
        const int idx_ = isc_ ? ic_ : isw_ ? iw_ : is_; const bf16* kb_s = isc_ ? kcseg : isw_ ? kwseg : ksseg; const bf16* vb_s = isc_ ? vcseg : isw_ ? vwseg : vsseg; \
        glds16s(kb_s + (size_t)idx_ * 4096, (unsigned)ksrc, (unsigned)__builtin_amdgcn_readfirstlane((int)(lds0 + (unsigned)((sbuf) + (b) * 16384) + wdst))); \
        glds16s(vb_s + (size_t)idx_ * 4096, (unsigned)vsrc, (unsigned)__builtin_amdgcn_readfirstlane((int)(lds0 + (unsigned)((sbuf) + (b) * 16384 + 8192) + wdst))); } while (0)
#pragma unroll
    for (int b = 0; b < NBS; ++b) NSA_STAGE(b, 0, b);
    float qq = 0.f;
#pragma unroll
    for (int s = 0; s < 4; ++s)
#pragma unroll
        for (int e = 0; e < 8; ++e) { const float v = bf2f((unsigned short)qf[s][e]); qq += v * v; }
    qq = half_sum(qq);
    const float kb_ = lut[131];
    const float lutfar = lut[r * LUTS + 129], mref = sqrtf(qq) * kb_ + lut[r * LUTS + 130];
    const int x7 = (c >> 1) & 7;
    const int kfo = c * 128;
    const int vsw = (lane >> 3) & 1;
    const int vfo = (4 * hi + ((lane & 15) >> 2)) * 128 + (16 * ((lane >> 4) & 1) + 4 * (lane & 3)) * 2 + vsw * 64;
    const int VD1 = 64 - 128 * vsw;
    f32x16 o0, o1;
#pragma unroll
    for (int i = 0; i < 16; ++i) { o0[i] = 0.f; o1[i] = 0.f; }
    float lsum = 0.f, linv_c = 0.f, carry = 0.f;
    asm volatile("s_waitcnt vmcnt(0) lgkmcnt(0)" ::: "memory");
    __syncthreads();
#define NSA_WINDOW_END() do { \
                const float gt2 = NSA_GATE(2); const float l = half_sum(lsum); const float sc = gt2 * (l > 0.f ? fast_rcp(l) : 0.f); \
                LAS unsigned* park = NSA_PARK; \
_Pragma("unroll") \
                for (int i = 0; i < 8; ++i) { const unsigned a_ = park[64 * i], b_ = park[64 * (8 + i)]; \
                    park[64 * i] = cvtpk(__uint_as_float(a_ << 16) + sc * o0[2 * i], __uint_as_float(a_ & 0xffff0000u) + sc * o0[2 * i + 1]); \
                    park[64 * (8 + i)] = cvtpk(__uint_as_float(b_ << 16) + sc * o1[2 * i], __uint_as_float(b_ & 0xffff0000u) + sc * o1[2 * i + 1]); } \
_Pragma("unroll") \
                for (int i = 0; i < 16; ++i) { o0[i] = 0.f; o1[i] = 0.f; } \
                lsum = 0.f; \
        } while (0)
    for (int st = 0; st < nstepsG; ++st) {
        const int sbuf = (st & 1) * NL_SBUF;
        if (st + 1 < nsteps) {
#pragma unroll
            for (int b = 0; b < NBS; ++b) NSA_STAGE((st + 1) * NBS + b, sbuf ^ NL_SBUF, b);
        }
#pragma unroll 1
        for (int b = 0; b < NBS; ++b) {
            const int ti = st * NBS + b;
            if (ti >= e3) break;
            if (ti >= e2 && ti < e2p) continue;
            const int mode = ti < e1 ? 0 : ti < e2 ? 1 : 3;
            int dbase, kstep, dmax; bool fast, colsel = true; int kind;
            if (mode < 2) { const int cc = mode == 0 ? ti : ti - e1; dbase = t - 16 * 64 * cc - 31; kstep = 16; dmax = 0x7fffffff; fast = (t0 - (16 * (64 * cc + 63) + 31)) >= 128; kind = fast ? 0 : 3; }
            else { const int ww = w0 + ti - e2p; dbase = t - 64 * ww; kstep = 1; dmax = WIN - 1; fast = (cur - ww) >= 3; kind = (cur - ww) <= 2 ? 1 : (cur - ww) <= 7 ? 0 : 2; }
            {
                const float cin = colsel ? (fast ? lutfar - mref : -mref) : -1e30f;
                f32x16 p0, p1;
#pragma unroll
                for (int i = 0; i < 16; ++i) { p0[i] = cin; p1[i] = cin; }
                NSA_READS(lds + sbuf + b * 16384 + kfo, lds + sbuf + b * 16384 + 8192 + vfo);
                NSA_QK();
                if (kind == 0) {
#pragma unroll
                    for (int i = 0; i < 16; ++i) { p0[i] = fast_exp2(p0[i]); p1[i] = fast_exp2(p1[i]); }
                } else if (kind == 1) NSA_SOFTMAX_NEAR(dbase);
                else if (kind == 2) NSA_SOFTMAX_FARMASK(dbase, dmax);
                else NSA_SOFTMAX_GENERAL(dbase);
                if (mode == 1) {
#pragma unroll
                    for (int i = 0; i < 16; ++i) { p0[i] *= linv_c; p1[i] *= linv_c; }
                    const int cc = ti - e1;
                    float A0[4], B0[4], A1[4], B1[4];
#pragma unroll
                    for (int q4 = 0; q4 < 4; ++q4) {
                        A0[q4] = p0[4 * q4] + p0[4 * q4 + 1] + p0[4 * q4 + 2] + 0.5f * p0[4 * q4 + 3]; B0[q4] = 0.5f * p0[4 * q4 + 3];
                        A1[q4] = p1[4 * q4] + p1[4 * q4 + 1] + p1[4 * q4 + 2] + 0.5f * p1[4 * q4 + 3]; B1[q4] = 0.5f * p1[4 * q4 + 3];
                        A0[q4] += dpp_x1(A0[q4]); A0[q4] += dpp_x2(A0[q4]); B0[q4] += dpp_x1(B0[q4]); B0[q4] += dpp_x2(B0[q4]);
                        A1[q4] += dpp_x1(A1[q4]); A1[q4] += dpp_x2(A1[q4]); B1[q4] += dpp_x1(B1[q4]); B1[q4] += dpp_x2(B1[q4]);
                    }
                    float Bl0[4], Bu0[4], Bl1[4], Bu1[4];
#pragma unroll
                    for (int q4 = 0; q4 < 4; ++q4) {
                        { auto rr = __builtin_amdgcn_permlane32_swap(__float_as_uint(B0[q4]), __float_as_uint(B0[q4]), false, false); Bl0[q4] = __uint_as_float(rr[0]); Bu0[q4] = __uint_as_float(rr[1]); }
                        { auto rr = __builtin_amdgcn_permlane32_swap(__float_as_uint(B1[q4]), __float_as_uint(B1[q4]), false, false); Bl1[q4] = __uint_as_float(rr[0]); Bu1[q4] = __uint_as_float(rr[1]); }
                    }
                    LAS float* irow = imp + tok * 132 + 16 * cc + hi;
#pragma unroll
                    for (int q4 = 0; q4 < 4; ++q4) {
                        const float s0 = hi ? Bl0[q4] : (q4 == 0 ? carry : Bu0[q4 - 1]);
                        const float s1 = hi ? Bl1[q4] : (q4 == 0 ? Bu0[3] : Bu1[q4 - 1]);
                        if (r == 0) { irow[2 * q4] = A0[q4] + s0; irow[8 + 2 * q4] = A1[q4] + s1; }
                    }
                    carry = Bu1[3];
                } else {
                    float s8[8];
#pragma unroll
                    for (int i = 0; i < 8; ++i) s8[i] = (p0[2 * i] + p0[2 * i + 1]) + (p1[2 * i] + p1[2 * i + 1]);
                    lsum += ((s8[0] + s8[1]) + (s8[2] + s8[3])) + ((s8[4] + s8[5]) + (s8[6] + s8[7]));
                }
                if (mode != 0) NSA_PV();
            }
            if (ti == e1 - 1) { const float l = half_sum(lsum); linv_c = l > 0.f ? fast_rcp(l) : 0.f; lsum = 0.f; carry = 0.f; }
            if (ti == e2 - 1) {
                asm volatile("s_waitcnt lgkmcnt(0)" ::: "memory");
                {
                    const int tk = lane >> 3, sub = lane & 7, j0 = sub * 16;
                    const LAS float* irow = imp + (8 * wave + tk) * 132 + j0;
                    unsigned s_[16];
#pragma unroll
                    for (int q = 0; q < 4; ++q) { const f32x4 v = *(const LAS f32x4*)(irow + 4 * q);
#pragma unroll
                        for (int e = 0; e < 4; ++e) { const int j = j0 + 4 * q + e; s_[4 * q + e] = (j >= 1 && j <= cur - 2) ? ((__float_as_uint(v[e]) & ~127u) | (unsigned)(127 - j)) : 0u; } }
#define CE(a_, b_) do { const unsigned hi_ = max(s_[a_], s_[b_]), lo_ = min(s_[a_], s_[b_]); s_[a_] = hi_; s_[b_] = lo_; } while (0)
                    CE(0, 1); CE(2, 3); CE(0, 2); CE(1, 3); CE(1, 2); CE(4, 5); CE(6, 7); CE(4, 6); CE(5, 7); CE(5, 6); CE(0, 4); CE(2, 6); CE(2, 4); CE(1, 5); CE(3, 7); CE(3, 5); CE(1, 2); CE(3, 4); CE(5, 6); CE(8, 9); CE(10, 11); CE(8, 10); CE(9, 11); CE(9, 10); CE(12, 13); CE(14, 15); CE(12, 14); CE(13, 15); CE(13, 14); CE(8, 12); CE(10, 14); CE(10, 12); CE(9, 13); CE(11, 15); CE(11, 13); CE(9, 10); CE(11, 12); CE(13, 14); CE(0, 8); CE(4, 12); CE(4, 8); CE(2, 10); CE(6, 14); CE(6, 10); CE(2, 4); CE(6, 8); CE(10, 12); CE(1, 9); CE(5, 13); CE(5, 9); CE(3, 11); CE(7, 15); CE(7, 11); CE(3, 5); CE(7, 9); CE(11, 13); CE(1, 2); CE(3, 4); CE(5, 6); CE(7, 8); CE(9, 10); CE(11, 12); CE(13, 14);
#undef CE
                    unsigned bits = 0u;
                    if (j0 == 0) bits |= 1u;
                    if ((cur >> 4) == sub) bits |= 1u << (cur & 15);
                    if (cur >= 1 && ((cur - 1) >> 4) == sub) bits |= 1u << ((cur - 1) & 15);
                    const int nforced = 1 + (cur >= 1 ? 1 : 0) + (cur >= 2 ? 1 : 0);
                    for (int it = nforced; it < NTOP; ++it) {
                        unsigned gm = s_[0];
                        gm = max(gm, (unsigned)__builtin_amdgcn_mov_dpp((int)gm, 0xB1, 0xf, 0xf, true));
                        gm = max(gm, (unsigned)__builtin_amdgcn_mov_dpp((int)gm, 0x4E, 0xf, 0xf, true));
                        gm = max(gm, (unsigned)__builtin_amdgcn_mov_dpp((int)gm, 0x141, 0xf, 0xf, true));
                        if (__ballot(gm != 0u) == 0ull) break;
                        const bool own = (s_[0] == gm) && gm != 0u;
                        bits |= own ? (1u << ((127u - (gm & 127u)) & 15u)) : 0u;
#pragma unroll
                        for (int i = 0; i < 15; ++i) s_[i] = own ? s_[i + 1] : s_[i];
                        s_[15] = own ? 0u : s_[15];
                    }
                    LAS unsigned short* sm16 = (LAS unsigned short*)(lds + NL_SELM);
                    sm16[(8 * wave + tk) * 8 + sub] = (unsigned short)bits;
                    asm volatile("s_waitcnt lgkmcnt(0)" ::: "memory");
                }
                { const float gt0 = NSA_GATE(0); LAS unsigned* park = NSA_PARK;
#pragma unroll
                  for (int i = 0; i < 8; ++i) { park[64 * i] = cvtpk(gt0 * o0[2 * i], gt0 * o0[2 * i + 1]); park[64 * (8 + i)] = cvtpk(gt0 * o1[2 * i], gt0 * o1[2 * i + 1]); }
#pragma unroll
                  for (int i = 0; i < 16; ++i) { o0[i] = 0.f; o1[i] = 0.f; } }
            }
            if (ti == e3 - 1) NSA_WINDOW_END();
        }
        asm volatile("s_waitcnt vmcnt(0) lgkmcnt(0)" ::: "memory");
        __syncthreads();
    }
    {
    const float mref_o = mref;
#define SBAR() __builtin_amdgcn_sched_barrier(0)
#define PIN(x) asm volatile("" : "+v"(x))
#define MFMA32(a, b, c) __builtin_amdgcn_mfma_f32_32x32x16_bf16(a, b, c, 0, 0, 0)
#define PKW(P, i) cvtpk_c(P[i], P[(i) + 1])
#define NB_KX(s) ((s) == 0 ? kx0 : (s) == 1 ? kx1 : (s) == 2 ? kx2 : kx3)
#define NB_KLD2(kk, s) do { const LAS unsigned char* kq_ = tb + (kk) * 16384 + kfo + NB_KX(s); kf[2 * (s)] = *(const LAS bf16x8_t*)(kq_); kf[2 * (s) + 1] = *(const LAS bf16x8_t*)(kq_ + 4096); } while (0)
#define NB_KRD(G, kk, s) do { if (G) { NB_KLD2(kk, s); SBAR(); } } while (0)
#define NB_VRD(j) do { vlo[j] = vtr(vq_ + ((j) >> 1) * 2048 + (((j) & 1) ? VD1 : 0)); vhi[j] = vtr(vq_ + ((j) >> 1) * 2048 + 1024 + (((j) & 1) ? VD1 : 0)); } while (0)
#define NB_VFR(j) (bf16x8_t){vlo[j][0], vlo[j][1], vlo[j][2], vlo[j][3], vhi[j][0], vhi[j][1], vhi[j][2], vhi[j][3]}
#define NB_PAF(k) __builtin_bit_cast(bf16x8_t, pw##k)
#define NB_GAPA(MF, a0, a1, a2, a3, D0, E0, D1, E1) do { MF; sacc += a0; sacc += a1; sacc += a2; sacc += a3; unsigned w0_ = E0, w1_ = E1; PIN(w0_); PIN(w1_); D0 = w0_; D1 = w1_; PIN(sacc); SBAR(); } while (0)
#define FIX0(x, i, H) (x)
#define FIXM(x, i, H) (((((i) & 3) + 8 * ((i) >> 2) + 32 * (H)) >= lo_) ? (x) : -1e30f)
#define FIX1(x, i, H) ((x) + rb_[32 * (H) + ((i) & 3) + 8 * ((i) >> 2)])
#define NB_GAPB(MF, X, i, H, FIX) do { MF; X[i] = fast_exp2(FIX(X[i], (i), H)); X[(i) + 1] = fast_exp2(FIX(X[(i) + 1], (i) + 1, H)); X[(i) + 2] = fast_exp2(FIX(X[(i) + 2], (i) + 2, H)); X[(i) + 3] = fast_exp2(FIX(X[(i) + 3], (i) + 3, H)); PIN(X); SBAR(); } while (0)
#define NB_GAPBP(OD, MF, X, i, H, FIX) do { MF; PIN(OD); X[i] = fast_exp2(FIX(X[i], (i), H)); X[(i) + 1] = fast_exp2(FIX(X[(i) + 1], (i) + 1, H)); X[(i) + 2] = fast_exp2(FIX(X[(i) + 2], (i) + 2, H)); X[(i) + 3] = fast_exp2(FIX(X[(i) + 3], (i) + 3, H)); PIN(X); SBAR(); } while (0)
#define NB_CIN(cval) f32x16 cinv; { float cin_ = (cval); asm volatile("" : "+v"(cin_));            \
        _Pragma("unroll") for (int i = 0; i < 16; ++i) cinv[i] = cin_; }
#define NB_HEAD(C0, C1, cval, kk, GL, knext, FIX) do { SBAR(); NB_KLD2(kk, 0); NB_KLD2(kk, 1); NB_KLD2(kk, 2); NB_KLD2(kk, 3); NB_CIN(cval); SBAR(); \
        C0 = MFMA32(kf[0], qf[0], cinv); C0 = MFMA32(kf[2], qf[1], C0); C0 = MFMA32(kf[4], qf[2], C0); C0 = MFMA32(kf[6], qf[3], C0); SBAR();            \
        C1 = MFMA32(kf[1], qf[0], cinv); SBAR(); \
        NB_GAPBP(C1, C1 = MFMA32(kf[3], qf[1], C1), C0, 0, 0, FIX); NB_GAPBP(C1, C1 = MFMA32(kf[5], qf[2], C1), C0, 4, 0, FIX); NB_GAPBP(C1, C1 = MFMA32(kf[7], qf[3], C1), C0, 8, 0, FIX); \
        if (GL) { NB_KLD2(knext, 0); NB_KLD2(knext, 1); NB_KLD2(knext, 2); NB_KLD2(knext, 3); SBAR(); } \
        NB_GAPB((void)0, C0, 12, 0, FIX); NB_GAPB((void)0, C1, 0, 1, FIX); NB_GAPB((void)0, C1, 4, 1, FIX); NB_GAPB((void)0, C1, 8, 1, FIX); NB_GAPB((void)0, C1, 12, 1, FIX); } while (0)
#define NB_STEP(C0, C1, cval, P0, P1, kprev, GL, knext, FIX) NB_STEPK(C0, C1, cval, P0, P1, kprev, GL, knext, FIX, false, 0)
#define NB_STEPK(C0, C1, cval, P0, P1, kprev, GL, knext, FIX, KL, kcur) do { SBAR(); if (KL) { NB_KLD2(kcur, 0); NB_KLD2(kcur, 1); NB_KLD2(kcur, 2); NB_KLD2(kcur, 3); SBAR(); }     \
        const LAS unsigned char* vq_ = tb + (kprev) * 16384 + 8192 + vfo; NB_CIN(cval); \
        float sacc = P0[0] + P0[1]; \
                           NB_GAPA(C0 = MFMA32(kf[0], qf[0], cinv), P0[2], P0[3], P0[4], P0[5],     pw0[0], PKW(P0, 0), pw0[1], PKW(P0, 2)); \
                           NB_GAPA(C1 = MFMA32(kf[1], qf[0], cinv), P0[6], P0[7], P0[8], P0[9],     pw0[2], PKW(P0, 4), pw0[3], PKW(P0, 6)); PIN(cinv); SBAR(); \
                           NB_GAPA(C0 = MFMA32(kf[2], qf[1], C0),   P0[10], P0[11], P0[12], P0[13], pw1[0], PKW(P0, 8), pw1[1], PKW(P0, 10)); \
                           NB_GAPA(C1 = MFMA32(kf[3], qf[1], C1),   P0[14], P0[15], P1[0], P1[1],   pw1[2], PKW(P0, 12), pw1[3], PKW(P0, 14)); \
        NB_VRD(0); SBAR(); NB_GAPA(C0 = MFMA32(kf[4], qf[2], C0),   P1[2], P1[3], P1[4], P1[5],     pw2[0], PKW(P1, 0), pw2[1], PKW(P1, 2)); \
        NB_VRD(1); SBAR(); NB_GAPA(C1 = MFMA32(kf[5], qf[2], C1),   P1[6], P1[7], P1[8], P1[9],     pw2[2], PKW(P1, 4), pw2[3], PKW(P1, 6)); \
        NB_VRD(2); SBAR(); NB_GAPA(C0 = MFMA32(kf[6], qf[3], C0),   P1[10], P1[11], P1[12], P1[13], pw3[0], PKW(P1, 8), pw3[1], PKW(P1, 10)); \
        NB_VRD(3); SBAR(); NB_GAPA(C1 = MFMA32(kf[7], qf[3], C1),   P1[14], P1[15], 0.f, 0.f,       pw3[2], PKW(P1, 12), pw3[3], PKW(P1, 14)); \
        lsum += sacc; SBAR(); \
        NB_VRD(4); SBAR(); NB_GAPBP(o0, o0 = MFMA32(NB_VFR(0), NB_PAF(0), o0), C0, 0, 0, FIX); \
        NB_VRD(5); SBAR(); NB_GAPBP(o1, o1 = MFMA32(NB_VFR(1), NB_PAF(0), o1), C0, 4, 0, FIX); \
        NB_VRD(6); SBAR(); NB_GAPBP(o0, o0 = MFMA32(NB_VFR(2), NB_PAF(1), o0), C0, 8, 0, FIX); \
        NB_VRD(7); SBAR(); NB_GAPBP(o1, o1 = MFMA32(NB_VFR(3), NB_PAF(1), o1), C0, 12, 0, FIX); \
        NB_KRD(GL, knext, 0); NB_GAPBP(o0, o0 = MFMA32(NB_VFR(4), NB_PAF(2), o0), C1, 0, 1, FIX); NB_KRD(GL, knext, 1); NB_GAPBP(o1, o1 = MFMA32(NB_VFR(5), NB_PAF(2), o1), C1, 4, 1, FIX); \
        NB_KRD(GL, knext, 2); NB_GAPBP(o0, o0 = MFMA32(NB_VFR(6), NB_PAF(3), o0), C1, 8, 1, FIX); NB_KRD(GL, knext, 3); NB_GAPBP(o1, o1 = MFMA32(NB_VFR(7), NB_PAF(3), o1), C1, 12, 1, FIX); \
        } while (0)
#define NB_TGAP(MF, a0, a1, a2, a3, a4, a5, a6, a7, D0, E0, D1, E1, D2, E2, D3, E3) do { MF; sacc += a0; sacc += a1; sacc += a2; sacc += a3; sacc += a4; sacc += a5; sacc += a6; sacc += a7; \
        unsigned w0_ = E0, w1_ = E1, w2_ = E2, w3_ = E3; PIN(w0_); PIN(w1_); PIN(w2_); PIN(w3_); D0 = w0_; D1 = w1_; D2 = w2_; D3 = w3_; PIN(sacc); SBAR(); } while (0)
#define NB_TAIL(P0, P1, kprev) do { SBAR(); const LAS unsigned char* vq_ = tb + (kprev) * 16384 + 8192 + vfo; \
        _Pragma("unroll") for (int j = 0; j < 8; ++j) NB_VRD(j); \
        float sacc = 0.f; \
        NB_TGAP((void)0, P0[0], P0[1], P0[2], P0[3], P0[4], P0[5], P0[6], P0[7], pw0[0], PKW(P0, 0), pw0[1], PKW(P0, 2), pw0[2], PKW(P0, 4), pw0[3], PKW(P0, 6)); \
        o0 = MFMA32(NB_VFR(0), NB_PAF(0), o0); \
        NB_TGAP(o1 = MFMA32(NB_VFR(1), NB_PAF(0), o1), P0[8], P0[9], P0[10], P0[11], P0[12], P0[13], P0[14], P0[15], pw1[0], PKW(P0, 8), pw1[1], PKW(P0, 10), pw1[2], PKW(P0, 12), pw1[3], PKW(P0, 14)); \
        o0 = MFMA32(NB_VFR(2), NB_PAF(1), o0); \
        NB_TGAP(o1 = MFMA32(NB_VFR(3), NB_PAF(1), o1), P1[0], P1[1], P1[2], P1[3], P1[4], P1[5], P1[6], P1[7], pw2[0], PKW(P1, 0), pw2[1], PKW(P1, 2), pw2[2], PKW(P1, 4), pw2[3], PKW(P1, 6)); \
        o0 = MFMA32(NB_VFR(4), NB_PAF(2), o0); \
        NB_TGAP(o1 = MFMA32(NB_VFR(5), NB_PAF(2), o1), P1[8], P1[9], P1[10], P1[11], P1[12], P1[13], P1[14], P1[15], pw3[0], PKW(P1, 8), pw3[1], PKW(P1, 10), pw3[2], PKW(P1, 12), pw3[3], PKW(P1, 14)); \
        o0 = MFMA32(NB_VFR(6), NB_PAF(3), o0); o1 = MFMA32(NB_VFR(7), NB_PAF(3), o1); lsum += sacc; SBAR(); } while (0)
#pragma unroll 1
    for (int st = nstepsG; st < nsteps; ++st) {
        f32x16 pA0, pA1, pB0, pB1; bf16x8_t kf[8]; v4i16_t vlo[8], vhi[8]; u32x4 pw0, pw1, pw2, pw3;
        const int lane = lane_fresh(), c = lane & 31, hi = lane >> 5, r = c & 3, tok = 8 * wave + (c >> 2), t = t0 + tok;
        const int x7 = (c >> 1) & 7, kfo = c * 128, vsw = (lane >> 3) & 1, vfo = (4 * hi + ((lane & 15) >> 2)) * 128 + (16 * ((lane >> 4) & 1) + 4 * (lane & 3)) * 2 + vsw * 64, VD1 = 64 - 128 * vsw;
        const int kx0 = ((0 + hi) ^ x7) << 4, kx1 = ((2 + hi) ^ x7) << 4, kx2 = ((4 + hi) ^ x7) << 4, kx3 = ((6 + hi) ^ x7) << 4;
        float mref = mref_o; asm volatile("" : "+v"(mref)); const float cfar = lut[r * LUTS + 129] - mref;
        if (st == nsteps - 1) {
    {
        const LAS unsigned char* tb = lds + ((nsteps - 1) & 1) * NL_SBUF;
        const LAS float* rlb = (const LAS float*)(lds + NL_RLUT) + r * RLS + 191 + 4 * hi;
        const LAS unsigned* swp = (const LAS unsigned*)(lds + NL_SELM + tok * 16);
#define NEAR_SETUP(b_) const int jj_ = (nf + (b_)) < cur ? (nf + (b_)) : cur; const bool cs_ = ((b_) < nn) && ((swp[jj_ >> 5] >> (jj_ & 31)) & 1u); \
        const LAS float* rb_ = rlb - (t - 64 * jj_); const float cv_ = cs_ ? -mref : -1e30f
        { NEAR_SETUP(0); NB_HEAD(pA0, pA1, cv_, 0, false, 0, FIX1); }
        { NEAR_SETUP(1); NB_STEPK(pB0, pB1, cv_, pA0, pA1, 0, false, 0, FIX1, true, 1); }
        { NEAR_SETUP(2); NB_STEPK(pA0, pA1, cv_, pB0, pB1, 1, false, 0, FIX1, true, 2); }
        NB_TAIL(pA0, pA1, 2);
#undef NEAR_SETUP
    }
            break;
        }
        if (st < nstepsA) {
            const int sbufw = (st & 1) * NL_SBUF;
#pragma unroll
            for (int b = 0; b < NBS; ++b) NSA_STAGE((st + 1) * NBS + b, sbufw ^ NL_SBUF, b);
            const LAS unsigned char* tb = lds + sbufw; const int sw = st - nstepsG; const int db0 = t - 64 * (w0 + 3 * sw);
            if (sw < 2) {
                { const int lo_ = db0 - (WIN - 1) - 4 * hi;       NB_HEAD(pA0, pA1, cfar, 0, false, 0, FIXM); }
                { const int lo_ = db0 - 64 - (WIN - 1) - 4 * hi;  NB_STEPK(pB0, pB1, cfar, pA0, pA1, 0, false, 0, FIXM, true, 1); }
                { const int lo_ = db0 - 128 - (WIN - 1) - 4 * hi; NB_STEPK(pA0, pA1, cfar, pB0, pB1, 1, false, 0, FIXM, true, 2); }
                NB_TAIL(pA0, pA1, 2);
            } else {
                const LAS float* rlb = (const LAS float*)(lds + NL_RLUT) + r * RLS + 191 + 4 * hi; const float cv_ = -mref;
                { const LAS float* rb_ = rlb - db0;         NB_HEAD(pA0, pA1, cv_, 0, false, 0, FIX1); }
                { const LAS float* rb_ = rlb - (db0 - 64);  NB_STEPK(pB0, pB1, cv_, pA0, pA1, 0, false, 0, FIX1, true, 1); }
                { const LAS float* rb_ = rlb - (db0 - 128); NB_STEPK(pA0, pA1, cv_, pB0, pB1, 1, false, 0, FIX1, true, 2); }
                NB_TAIL(pA0, pA1, 2);
                NSA_WINDOW_END();
            }
            asm volatile("s_waitcnt vmcnt(0) lgkmcnt(0)" ::: "memory");
            __syncthreads();
            continue;
        }
        const int sbuf = (st & 1) * NL_SBUF;
        const int j0 = (st - nstepsA) * NBS;
        const LAS unsigned* swp = (const LAS unsigned*)(lds + NL_SELM + tok * 16);
        const int wi = j0 >> 5; const unsigned wa_ = swp[wi], wb_ = swp[wi < 3 ? wi + 1 : 3];
        {
          const int jn = j0 + NBS; const bool nextnear = jn >= nfp;
#pragma unroll
          for (int b = 0; b < NBS; ++b) { int jj = nextnear ? nf + b : jn + b; const int jmax = nextnear ? cur : nf - 1; jj = jj < jmax ? jj : jmax;
              glds16s(ksseg + (size_t)jj * 4096, (unsigned)ksrc, (unsigned)__builtin_amdgcn_readfirstlane((int)(lds0 + (unsigned)((sbuf ^ NL_SBUF) + b * 16384) + wdst)));
              glds16s(vsseg + (size_t)jj * 4096, (unsigned)vsrc, (unsigned)__builtin_amdgcn_readfirstlane((int)(lds0 + (unsigned)((sbuf ^ NL_SBUF) + b * 16384 + 8192) + wdst))); } }
        const int bend = (nf - j0) < NBS ? (nf - j0) : NBS;
        {
            const unsigned sel3 = (unsigned)((((unsigned long long)wb_ << 32) | wa_) >> (j0 & 31));
            const bool cs0 = sel3 & 1u, cs1 = (1 < bend) && (sel3 & 2u), cs2 = (2 < bend) && (sel3 & 4u);
            const bool n0 = __ballot(cs0) != 0ull, n1 = __ballot(cs1) != 0ull, n2 = __ballot(cs2) != 0ull;
            const int cnt = (n0 ? 1 : 0) + (n1 ? 1 : 0) + (n2 ? 1 : 0);
            const int ka = n0 ? 0 : n1 ? 1 : 2, kb2 = (n0 && n1) ? 1 : 2;
            const bool csa = ka == 0 ? cs0 : ka == 1 ? cs1 : cs2, csb = kb2 == 1 ? cs1 : cs2, csc = cs2;
            const LAS unsigned char* tb = lds + sbuf;
            if (wave >= 4) __builtin_amdgcn_s_barrier();
            if (cnt == 1) { NB_HEAD(pA0, pA1, (csa ? cfar : -1e30f), ka, false, 0, FIX0); NB_TAIL(pA0, pA1, ka); }
            else if (cnt == 2) { NB_HEAD(pA0, pA1, (csa ? cfar : -1e30f), ka, true, kb2, FIX0); NB_STEP(pB0, pB1, (csb ? cfar : -1e30f), pA0, pA1, ka, false, 0, FIX0); NB_TAIL(pB0, pB1, kb2); }
            else if (cnt == 3) { NB_HEAD(pA0, pA1, (csa ? cfar : -1e30f), 0, true, 1, FIX0); NB_STEP(pB0, pB1, (csb ? cfar : -1e30f), pA0, pA1, 0, true, 2, FIX0); NB_STEP(pA0, pA1, (csc ? cfar : -1e30f), pB0, pB1, 1, false, 0, FIX0); NB_TAIL(pA0, pA1, 2); }
            if (wave < 4) __builtin_amdgcn_s_barrier();
        }
        asm volatile("s_waitcnt vmcnt(0) lgkmcnt(0)" ::: "memory");
        __syncthreads();
    }
#undef NB_KX
#undef NB_KLD2
#undef NB_KRD
#undef NB_VRD
#undef NB_VFR
#undef NB_PAF
#undef NB_GAPA
#undef NB_GAPB
#undef NB_GAPBP
#undef NB_CIN
#undef NB_HEAD
#undef NB_STEP
#undef NB_STEPK
#undef NB_TAIL
#undef NB_TGAP
    }
#undef NSA_STAGE
#undef NSA_GATE
#undef NSA_WINDOW_END
#undef NSA_PARK
    { const int lane2 = lane_fresh(), wave2 = wave, c2 = lane2 & 31, hi2 = lane2 >> 5, r2 = c2 & 3;
      const size_t tl2 = (size_t)bl * SEQ + qb * 64 + 8 * wave2 + (c2 >> 2);
      const float gt1b = P.gates[tl2 * 48 + (g * 4 + r2) * 3 + 1];
      const float l = half_sum(lsum); const float sc = gt1b * (l > 0.f ? fast_rcp(l) : 0.f);
      const LAS unsigned* park = (const LAS unsigned*)(lds + NL_IMP) + wave2 * 1056 + lane2;
      bf16* orow = P.onsa + tl2 * DM + (g * 4 + r2) * 64; const int hi = hi2;
#pragma unroll
      for (int q4 = 0; q4 < 4; ++q4) {
          const unsigned a0 = park[64 * (2 * q4)], a1 = park[64 * (2 * q4 + 1)], b0 = park[64 * (8 + 2 * q4)], b1 = park[64 * (8 + 2 * q4 + 1)];
          u32x2 w0_; w0_.x = cvtpk(__uint_as_float(a0 << 16) + sc * o0[4 * q4], __uint_as_float(a0 & 0xffff0000u) + sc * o0[4 * q4 + 1]);
                     w0_.y = cvtpk(__uint_as_float(a1 << 16) + sc * o0[4 * q4 + 2], __uint_as_float(a1 & 0xffff0000u) + sc * o0[4 * q4 + 3]);
          u32x2 w1_; w1_.x = cvtpk(__uint_as_float(b0 << 16) + sc * o1[4 * q4], __uint_as_float(b0 & 0xffff0000u) + sc * o1[4 * q4 + 1]);
                     w1_.y = cvtpk(__uint_as_float(b1 << 16) + sc * o1[4 * q4 + 2], __uint_as_float(b1 & 0xffff0000u) + sc * o1[4 * q4 + 3]);
          *(u32x2*)(orow + 8 * q4 + 4 * hi) = w0_; *(u32x2*)(orow + 32 + 8 * q4 + 4 * hi) = w1_;
      } }
    asm volatile("s_waitcnt lgkmcnt(0)" ::: "memory");
    __syncthreads();
}
#undef NSA_READS
#undef NSA_VREADS01
#undef NSA_SOFTMAX_NEAR
#undef NSA_SOFTMAX_FARMASK
#undef NSA_QK
#undef NSA_PV
#undef NSA_SOFTMAX_GENERAL

constexpr int ML_A = 0, ML_ABUF = 32768, ML_B = 65536, ML_BBUF = 32768;
__device__ __forceinline__ void mem_unit_lds(const bf16* qm, const bf16* kmn, const bf16* vmt, bf16* omem, LAS unsigned char* lds, int tl0, int bglob, int hm, float mref, const int wave, const bool first, const bf16* kb_next, bf16x8_t (&qf)[16], const bf16* qm_next) {
    const int lane = lane_fresh(), tid = wave * 64 + lane, c = lane & 31, hi = lane >> 5;
    const unsigned lds0 = (unsigned)(uintptr_t)lds;
    { const bf16* qrow = qm + (size_t)(tl0 + 32 * wave + c) * DM + hm * MHD + 8 * hi;
#pragma unroll
      for (int s = 0; s < 16; ++s) qf[s] = *(const bf16x8_t*)(qrow + 16 * s); }
    const bf16* kb = kmn + (size_t)(bglob * MH + hm) * NMEM * MHD;
    const bf16* vb = vmt + (size_t)(bglob * MH + hm) * NMEM * MHD;
    int ksrc[4], vsrc[2];
#pragma unroll
    for (int i = 0; i < 4; ++i) { const int p = i * 512 + tid, row = p >> 5, ch = (p & 31) ^ (row & 15); ksrc[i] = (row * MHD + ch * 8) * 2; }
#pragma unroll
    for (int i = 0; i < 2; ++i) { const int p = i * 512 + tid, row = p >> 3, sl = (p & 7) ^ ((row >> 1) & 7); vsrc[i] = (row * NMEM + sl * 8) * 2; }
    const unsigned wdst = (unsigned)wave * 1024u;
#define MEM_DMA_K(kbase, mt, buf) do { _Pragma("unroll") for (int i_ = 0; i_ < 4; ++i_) \
        glds16((const char*)((kbase) + (size_t)(64 * (mt)) * MHD) + ksrc[i_], (unsigned)__builtin_amdgcn_readfirstlane((int)(lds0 + ML_A + (buf) * ML_ABUF + i_ * 8192 + wdst))); } while (0)
#define MEM_DMA_V(j, buf) do { _Pragma("unroll") for (int h_ = 0; h_ < 2; ++h_) { const int it_ = 2 * (j) + h_; _Pragma("unroll") for (int i_ = 0; i_ < 2; ++i_) \
        glds16((const char*)(vb + (size_t)(128 * (it_ >> 2)) * NMEM + 64 * (it_ & 3)) + vsrc[i_], (unsigned)__builtin_amdgcn_readfirstlane((int)(lds0 + ML_B + (buf) * ML_BBUF + h_ * 16384 + i_ * 8192 + wdst))); } } while (0)
    if (first) { MEM_DMA_K(kb, 0, 0); MEM_DMA_K(kb, 1, 1); }
    MEM_DMA_V(0, 0); MEM_DMA_V(1, 1);
    asm volatile("s_waitcnt vmcnt(8)" ::: "memory");
    float ss = 0.f;
#pragma unroll
    for (int s = 0; s < 16; ++s)
#pragma unroll
        for (int e = 0; e < 8; ++e) { const float v = bf2f((unsigned short)qf[s][e]); ss += v * v; }
    ss = half_sum(ss);
    const float f = rsqrtf(ss * (1.f / MHD) + EPS) * (LOG2E / 16.f);
    asm volatile("s_waitcnt lgkmcnt(0)" ::: "memory");
    __syncthreads();
    u32x4 pk[4][4]; float lsum = 0.f;
    const int kfo = c * 512, x15 = c & 15;
#pragma unroll
    for (int mt = 0; mt < 4; ++mt) {
        f32x16 p0, p1;
#pragma unroll
        for (int i = 0; i < 16; ++i) { p0[i] = 0.f; p1[i] = 0.f; }
        const LAS unsigned char* ka = lds + ML_A + (mt & 1) * ML_ABUF + kfo;
#pragma unroll
        for (int s = 0; s < 16; ++s) {
            const bf16x8_t a0 = *(const LAS bf16x8_t*)(ka + (((2 * s + hi) ^ x15) << 4)), a1 = *(const LAS bf16x8_t*)(ka + 32 * 512 + (((2 * s + hi) ^ x15) << 4));
            p0 = __builtin_amdgcn_mfma_f32_32x32x16_bf16(a0, qf[s], p0, 0, 0, 0);
            p1 = __builtin_amdgcn_mfma_f32_32x32x16_bf16(a1, qf[s], p1, 0, 0, 0);
            if ((s & 3) == 3) { __builtin_amdgcn_sched_group_barrier(0x100, 8, 0); __builtin_amdgcn_sched_group_barrier(0x008, 8, 0); __builtin_amdgcn_sched_barrier(0); }
        }
        float sm = 0.f;
#pragma unroll
        for (int i = 0; i < 16; ++i) { p0[i] = fast_exp2(p0[i] * f - mref); p1[i] = fast_exp2(p1[i] * f - mref); sm += p0[i] + p1[i]; }
        lsum += sm;
        pk[mt][0] = (u32x4){cvtpk(p0[0], p0[1]), cvtpk(p0[2], p0[3]), cvtpk(p0[4], p0[5]), cvtpk(p0[6], p0[7])};
        pk[mt][1] = (u32x4){cvtpk(p0[8], p0[9]), cvtpk(p0[10], p0[11]), cvtpk(p0[12], p0[13]), cvtpk(p0[14], p0[15])};
        pk[mt][2] = (u32x4){cvtpk(p1[0], p1[1]), cvtpk(p1[2], p1[3]), cvtpk(p1[4], p1[5]), cvtpk(p1[6], p1[7])};
        pk[mt][3] = (u32x4){cvtpk(p1[8], p1[9]), cvtpk(p1[10], p1[11]), cvtpk(p1[12], p1[13]), cvtpk(p1[14], p1[15])};
        asm volatile("s_waitcnt vmcnt(0) lgkmcnt(0)" ::: "memory");
        __syncthreads();
        if (mt < 2) MEM_DMA_K(kb, mt + 2, mt & 1);
    }
    if (kb_next != nullptr) { MEM_DMA_K(kb_next, 0, 0); MEM_DMA_K(kb_next, 1, 1);
        const bf16* qrn = qm_next + (size_t)(32 * wave + c) * DM + 8 * hi;
#pragma unroll
        for (int s = 0; s < 16; ++s) glds16((const char*)(qrn + 16 * s), (unsigned)__builtin_amdgcn_readfirstlane((int)(lds0 + ML_B + 2 * ML_BBUF + wdst))); }
    const float linv = fast_rcp(half_sum(lsum));
    bf16* orow = omem + (size_t)(tl0 + 32 * wave + c) * DM + hm * MHD + 4 * hi;
    const int vx = (c >> 1) & 7;
    f32x16 o[4];
#pragma unroll
    for (int it = 0; it < 8; ++it) {
        const int dh = it >> 2, mt = it & 3, j = it >> 1;
        if (mt == 0) {
#pragma unroll
            for (int dt = 0; dt < 4; ++dt)
#pragma unroll
                for (int i = 0; i < 16; ++i) o[dt][i] = 0.f;
        }
        const LAS unsigned char* va = lds + ML_B + (j & 1) * ML_BBUF + (it & 1) * 16384 + c * 128;
#pragma unroll
        for (int ks = 0; ks < 4; ++ks) {
            const bf16x8_t pb = __builtin_bit_cast(bf16x8_t, pk[mt][ks]);
#pragma unroll
            for (int dt = 0; dt < 4; ++dt) {
                const bf16x8_t vf = *(const LAS bf16x8_t*)(va + dt * 32 * 128 + (((2 * ks + hi) ^ vx) << 4));
                o[dt] = __builtin_amdgcn_mfma_f32_32x32x16_bf16(vf, pb, o[dt], 0, 0, 0);
            }
            __builtin_amdgcn_sched_group_barrier(0x100, 4, 0); __builtin_amdgcn_sched_group_barrier(0x008, 4, 0); __builtin_amdgcn_sched_barrier(0);
        }
        if (it & 1) asm volatile("s_waitcnt vmcnt(0)" ::: "memory");
        if (mt == 3) {
#pragma unroll
            for (int dt = 0; dt < 4; ++dt)
#pragma unroll
                for (int q4 = 0; q4 < 4; ++q4) {
                    u32x2 w; w.x = cvtpk(o[dt][4 * q4] * linv, o[dt][4 * q4 + 1] * linv); w.y = cvtpk(o[dt][4 * q4 + 2] * linv, o[dt][4 * q4 + 3] * linv);
                    *(u32x2*)(orow + 128 * dh + 32 * dt + 8 * q4) = w;
                }
        }
        if (it & 1) {
            asm volatile("s_waitcnt lgkmcnt(0)" ::: "memory");
            __syncthreads();
            if (j < 2) MEM_DMA_V(j + 2, j & 1);
        }
    }
#undef MEM_DMA_K
#undef MEM_DMA_V
}

#define ssq0 ((float*)(ws + OFF_SSQ0))
#define ssq1 ((float*)(ws + OFF_SSQ1))
#define ssq2 ((float*)(ws + OFF_SSQ2))
#define bias1 ((float*)(ws + OFF_BIAS1))
#define WC2T ((bf16*)(ws + OFF_WC2T))
#define W1T ((bf16*)(ws + WS_W1T))
#define W2T ((bf16*)(ws + WS_W2T))
#define WINT ((bf16*)(ws + WS_WINT))
#define WOT ((bf16*)(ws + WS_WOT))
#define W3T ((bf16*)(ws + WS_W3T))
#define W4T ((bf16*)(ws + WS_W4T))
#define WC1T ((bf16*)(ws + WS_WC1T))
#define WMKVT ((bf16*)(ws + WS_WMKVT))
#define MEMN ((bf16*)(ws + WS_MEMN))
#define KM ((bf16*)(ws + WS_KM))
#define VM ((bf16*)(ws + WS_VM))
#define KCMP ((bf16*)(ws + WS_KCMP))
#define HID ((bf16*)(ws + WS_HID))
#define ACT ((bf16*)(ws + WS_A))
#define MG ((unsigned char*)(ws + WS_MG))
#define GB ((bf16*)(ws + WS_GB))
#define UB ((bf16*)(ws + WS_U))
#define QM ((bf16*)out + (size_t)T * DM)
#define XB ((bf16*)(ws + WS_XB))
#define QN ((bf16*)out)
#define KV ((bf16*)(ws + WS_KV))
#define GATES ((float*)(ws + WS_GATES))
#define MERGED ((bf16*)(ws + WS_MERGED))
#define OMEM QM


typedef __attribute__((address_space(1))) unsigned gu32;
#define XB_TMO      128
#define XB_XCNT(j)  (256  + 64 * (j))
#define XB_XSUB(j)  (1280 + 64 * (j))
#define XB_XGEN(j)  (2304 + 64 * (j))
#define XB_TOP      3328
#define XB_TOPGEN   3392
#define XCD_BAR_WORDS 3456
#define XB_SPIN_CAP (1u << 18)

__device__ __forceinline__ unsigned xb_ld(unsigned* p)              { return __hip_atomic_load(p, __ATOMIC_RELAXED, __HIP_MEMORY_SCOPE_AGENT); }
__device__ __forceinline__ unsigned xb_add(unsigned* p, unsigned v) { return __hip_atomic_fetch_add(p, v, __ATOMIC_RELAXED, __HIP_MEMORY_SCOPE_AGENT); }
__device__ __forceinline__ unsigned xb_xcc_id() { return (unsigned)__builtin_amdgcn_s_getreg((3 << 11) | 20) & 0xFu; }
#define XB_SPIN(cond, bar) do { unsigned _sp = 0; while (cond) { __builtin_amdgcn_s_sleep(1); \
    if ((++_sp & 255u) == 0u) { if (xb_ld(&(bar)[XB_TMO])) break; if (_sp > XB_SPIN_CAP) { atomicAdd(&(bar)[XB_TMO], 1u); break; } } } } while (0)

struct XcdBarrier {
    unsigned* bar; unsigned x; int wv;
    volatile LAS unsigned* st;
};

__device__ __forceinline__ XcdBarrier xcd_barrier_post(unsigned* bar, volatile LAS unsigned* st, int wv) {
    XcdBarrier b; b.bar = bar; b.x = xb_xcc_id(); b.st = st; b.wv = wv;
    if (wv == 0 && lane_fresh() == 0) (void)xb_add(&bar[XB_XCNT(b.x)], 1u);
    return b;
}
__device__ __forceinline__ void xcd_barrier_complete(unsigned* bar, unsigned x, unsigned& nloc, unsigned& nx) {
    const unsigned G = gridDim.x * gridDim.y * gridDim.z;
    unsigned sum, cnt, mine, sp = 0u;
    for (;;) {
        sum = 0u; cnt = 0u; mine = 0u;
#pragma unroll
        for (unsigned j = 0; j < 16; ++j) { const unsigned c = xb_ld(&bar[XB_XCNT(j)]); sum += c; cnt += (c > 0u) ? 1u : 0u; mine = (j == x) ? c : mine; }
        if (sum == G) break;
        __builtin_amdgcn_s_sleep(1);
        if ((++sp & 255u) == 0u) { if (xb_ld(&bar[XB_TMO])) break; if (sp > XB_SPIN_CAP) { atomicAdd(&bar[XB_TMO], 1u); break; } }
    }
    nloc = mine > 0u ? mine : 1u; nx = cnt > 0u ? cnt : 1u;
}

__device__ __forceinline__ void xcd_barrier(const XcdBarrier& b) {
    asm volatile("s_waitcnt vmcnt(0)" ::: "memory");
    __syncthreads();
    if (b.wv == 0 && lane_fresh() == 0) {
        unsigned* bar = b.bar; unsigned bx_ = b.x;
        asm volatile("" : "+s"(bar), "+s"(bx_));
        __builtin_amdgcn_s_waitcnt(0);
        unsigned nloc = b.st[0], nx = b.st[1];
        if (nloc == 0u) { xcd_barrier_complete(bar, bx_, nloc, nx); b.st[0] = nloc; b.st[1] = nx; }
        const unsigned old = xb_add(&bar[XB_XSUB(bx_)], 1u);
        const unsigned gen = old / nloc;
        if (old + 1u == (gen + 1u) * nloc) {
            __builtin_amdgcn_fence(__ATOMIC_RELEASE, "agent");
            asm volatile("s_waitcnt vmcnt(0)" ::: "memory");
            const unsigned og = xb_add(&bar[XB_TOP], 1u);
            const unsigned tg = og / nx;
            if (og + 1u == (tg + 1u) * nx) xb_add(&bar[XB_TOPGEN], 1u);
            else XB_SPIN(xb_ld(&bar[XB_TOPGEN]) == tg, bar);
            __builtin_amdgcn_fence(__ATOMIC_ACQUIRE, "agent");
            xb_add(&bar[XB_XGEN(bx_)], 1u);
            asm volatile("s_waitcnt vmcnt(0)" ::: "memory");
        } else {
            XB_SPIN(xb_ld(&bar[XB_XGEN(bx_)]) == gen, bar);
            __builtin_amdgcn_fence(__ATOMIC_ACQUIRE, "agent");
            asm volatile("s_waitcnt vmcnt(0)" ::: "memory");
        }
    }
    __syncthreads();
}


__global__ void __launch_bounds__(512, 2) fwd_megakernel(Args args) {
    extern __shared__ __attribute__((aligned(16))) unsigned char lds_raw[];
    LAS unsigned char* lds = (LAS unsigned char*)lds_raw;
    const int wave = __builtin_amdgcn_readfirstlane((int)threadIdx.x >> 6);
    const int G = gridDim.x, bx = blockIdx.x;
    const int gw = bx * 8 + wave, NGW = G * 8;
    unsigned char* ws = args.ws;
    { volatile LAS unsigned* st = (volatile LAS unsigned*)(lds + LDS_BYTES - 64); const int t_ = wave * 64 + lane_fresh(); if (t_ < 8) st[t_] = 0u; }
    __syncthreads();
    const XcdBarrier bar = xcd_barrier_post((unsigned*)(ws + WS_CTL), (volatile LAS unsigned*)(lds + LDS_BYTES - 64), wave);
    const float* x = args.in[I_X]; float* out = args.out;

    {
        const int lane = lane_fresh();
        LAS float* scr = (LAS float*)(lds + wave * 16640);
        constexpr int I1 = (DM / 64) * (FF2 / 64), I2 = (FF / 64) * (DM / 64), I3 = (DM / 64) * (INWP / 64), I4 = (DM / 64) * (DM / 64);
        constexpr int I7 = (2048 / 64) * (256 / 64), I9 = (DM / 64) * (2048 / 64);
        constexpr int NITEMS = 2 * I1 + 2 * I2 + I3 + I4 + 2 * I7 + I9 + 8;
        for (int it = gw; it < NITEMS; it += NGW) {
            int r = it;
            if (r < I1) { transpose_item64<1>(args.in[I_F1WI], DM, FF2, args.in[I_F1G], W1T, scr, r, lane); continue; } r -= I1;
            if (r < I3) { transpose_item64<2>(args.in[I_WIN], DM, INW, args.in[I_MIXG], WINT, scr, r, lane); continue; } r -= I3;
            if (r < I1) { transpose_item64<1>(args.in[I_F2WI], DM, FF2, args.in[I_F2G], W3T, scr, r, lane); continue; } r -= I1;
            if (r < I2) { transpose_item64<0>(args.in[I_F1WO], FF, DM, nullptr, W2T, scr, r, lane); continue; } r -= I2;
            if (r < I2) { transpose_item64<0>(args.in[I_F2WO], FF, DM, nullptr, W4T, scr, r, lane); continue; } r -= I2;
            if (r < I4) { transpose_item64<0>(args.in[I_WOUT], DM, DM, nullptr, WOT, scr, r, lane); continue; } r -= I4;
            if (r < I7) { transpose_item64<0>(args.in[I_W1K], 2048, 256, nullptr, WC1T, scr, r, lane); continue; } r -= I7;
            if (r < I7) { transpose_item64<0>(args.in[I_W1V], 2048, 256, nullptr, WC1T + (size_t)256 * 2048, scr, r, lane); continue; } r -= I7;
            if (r < I9) { transpose_item64<0>(args.in[I_WMKV], DM, 2048, args.in[I_MEMG], WMKVT, scr, r, lane); continue; } r -= I9;
            if (r < 4) { transpose_item64<0>(args.in[I_W2K], 256, 64, nullptr, WC2T, scr, r, lane); continue; } r -= 4;
            transpose_item64<0>(args.in[I_W2V], 256, 64, nullptr, WC2T + 64 * 256, scr, r, lane);
        }
        for (int row = gw; row < T; row += 2 * NGW) {
            const int row2 = row + NGW;
            const bool has2 = row2 < T; const int rb = has2 ? row2 : row;
            const f32x4* xa = (const f32x4*)(x + (size_t)row * DM) + lane; const f32x4* xc = (const f32x4*)(x + (size_t)rb * DM) + lane;
            f32x4 va[4], vb[4];
#pragma unroll
            for (int j = 0; j < 4; ++j) { va[j] = xa[64 * j]; vb[j] = xc[64 * j]; }
            float sa = 0.f, sb = 0.f;
            u32x2* oa = (u32x2*)(XB + (size_t)row * DM) + lane; u32x2* ob = (u32x2*)(XB + (size_t)rb * DM) + lane;
#pragma unroll
            for (int j = 0; j < 4; ++j) {
                sa += va[j][0] * va[j][0] + va[j][1] * va[j][1] + va[j][2] * va[j][2] + va[j][3] * va[j][3];
                sb += vb[j][0] * vb[j][0] + vb[j][1] * vb[j][1] + vb[j][2] * vb[j][2] + vb[j][3] * vb[j][3];
                u32x2 w; w.x = pk2(va[j][0], va[j][1]); w.y = pk2(va[j][2], va[j][3]); oa[64 * j] = w;
                if (has2) { u32x2 w2; w2.x = pk2(vb[j][0], vb[j][1]); w2.y = pk2(vb[j][2], vb[j][3]); ob[64 * j] = w2; } }
            sa = wave_sum(sa); sb = wave_sum(sb);
            if (lane == 0) { ssq0[row] = sa; ssq1[row] = 0.f; ssq2[row] = 0.f; if (has2) { ssq0[row2] = sb; ssq1[row2] = 0.f; ssq2[row2] = 0.f; } }
        }
        for (int row = gw; row < NB * NMEM; row += NGW) {
            const f32x4* xr = (const f32x4*)(args.in[I_MEM] + (size_t)row * DM) + lane; f32x4 v[4]; float ss = 0.f;
#pragma unroll
            for (int j = 0; j < 4; ++j) { v[j] = xr[64 * j]; ss += v[j][0] * v[j][0] + v[j][1] * v[j][1] + v[j][2] * v[j][2] + v[j][3] * v[j][3]; }
            const float rs = rsqrtf(wave_sum(ss) * (1.f / DM) + EPS);
            u32x2* o8 = (u32x2*)(MEMN + (size_t)row * DM) + lane;
#pragma unroll
            for (int j = 0; j < 4; ++j) { u32x2 w; w.x = pk2(v[j][0] * rs, v[j][1] * rs); w.y = pk2(v[j][2] * rs, v[j][3] * rs); o8[64 * j] = w; }
        }
        for (int o = gw; o < 512; o += NGW) {
            const int kvsel = o >> 8, n = o & 255; const float* pe = args.in[kvsel ? I_PEV : I_PEK]; const float* w1 = args.in[kvsel ? I_W1V : I_W1K];
            float s = 0.f;
            for (int k = lane; k < 2048; k += 64) s += pe[k] * w1[(size_t)k * 256 + n];
            s = wave_sum(s); if (lane == 0) bias1[o] = s;
        }
    }
    xcd_barrier(bar);

    {
        pg8::Gemm g{XB, W1T, T, FF2, DM, DM}; pg8::StaticOrder S; S.init(T, FF2, G, bx);
        EpiSwiglu E{ACT, ssq0};
        pg8::gemm_phase<EpiSwiglu, pg8::StaticOrder, true, true>(lds, g, S, E, wave);
    }
    {
        pg8::Gemm g{MEMN, WMKVT, NB * NMEM, 2048, DM, DM}; pg8::StaticOrder S; S.init(NB * NMEM, 2048, G, bx);
        EpiMemKV E{KM, VM};
        pg8::gemm_phase<EpiMemKV, pg8::StaticOrder, true, true>(lds, g, S, E, wave);
    }
    xcd_barrier(bar);

    {
        const int lane_ = lane_fresh();
        for (int row = gw; row < NB * MH * NMEM; row += NGW) {
            bf16* kr = KM + (size_t)row * MHD + lane_ * 4; const u32x2 w = *(const u32x2*)kr;
            float k[4]; k[0] = __uint_as_float(w.x << 16); k[1] = __uint_as_float(w.x & 0xffff0000u); k[2] = __uint_as_float(w.y << 16); k[3] = __uint_as_float(w.y & 0xffff0000u);
            const float rs = rsqrtf(wave_sum(k[0] * k[0] + k[1] * k[1] + k[2] * k[2] + k[3] * k[3]) * (1.f / MHD) + EPS);
            const f32x4 gk = *(const f32x4*)(args.in[I_MKG] + lane_ * 4), gq = *(const f32x4*)(args.in[I_MQG] + lane_ * 4);
            u32x2 o; o.x = pk2(k[0] * rs * gk[0] * gq[0], k[1] * rs * gk[1] * gq[1]); o.y = pk2(k[2] * rs * gk[2] * gq[2], k[3] * rs * gk[3] * gq[3]);
            *(u32x2*)kr = o;
        }
        pg8::Gemm g{ACT, W2T, T, DM, FF, FF}; pg8::StaticOrder S; S.init(T, DM, G, bx);
        EpiResidB<false> E{XB, 0.5f, ssq1, nullptr};
        pg8::gemm_phase<EpiResidB<false>, pg8::StaticOrder, true, true>(lds, g, S, E, wave);
    }
    xcd_barrier(bar);

    for (int ch = 0; ch < NCHUNK; ++ch) {
        const int tok0 = ch * TC;
        {
            pg8::Gemm g{XB + (size_t)tok0 * DM, WINT, TC, INWP, DM, DM}; pg8::StaticOrder S; S.init(TC, INWP, G, bx);
            EpiMix E{ssq1 + tok0, args.in[I_QG], args.in[I_KG], QN, KV, GATES, UB, GB, QM, MG};
            pg8::gemm_phase<EpiMix, pg8::StaticOrder, true, true>(lds, g, S, E, wave);
        }
        xcd_barrier(bar);
        {
            constexpr int NU = 2 * BPC * NG * NCMPP / 256;
            pg8::Gemm g{KV, WC1T, NU * 256, 512, 2048, 1024}; pg8::PairOrder S{NU, NU / 2, G, bx};
            EpiHid E{HID, bias1};
            pg8::gemm_phase<EpiHid, pg8::PairOrder, false, true>(lds, g, S, E, wave);
            asm volatile("s_waitcnt vmcnt(0)" ::: "memory");
            __syncthreads();
            const int lane_ = lane_fresh();
            if (bx < NU) {
                const int kvsel = bx / (NU / 2); const int c = lane_ & 31, hi = lane_ >> 5; const int row = bx * 256 + wave * 32 + c;
                const bf16* hrow = HID + (size_t)row * 256 + 8 * hi; const bf16* wrow = WC2T + (size_t)kvsel * 64 * 256 + (size_t)c * 256 + 8 * hi;
                f32x16 a0, a1;
#pragma unroll
                for (int i = 0; i < 16; ++i) { a0[i] = 0.f; a1[i] = 0.f; }
                bf16x8_t hbv[16], w0v[16], w1v[16];
#pragma unroll
                for (int s2 = 0; s2 < 16; ++s2) { hbv[s2] = *(const bf16x8_t*)(hrow + 16 * s2); w0v[s2] = *(const bf16x8_t*)(wrow + 16 * s2); w1v[s2] = *(const bf16x8_t*)(wrow + 32 * 256 + 16 * s2); }
                __builtin_amdgcn_sched_barrier(0);
#pragma unroll
                for (int s2 = 0; s2 < 16; ++s2) {
                    a0 = __builtin_amdgcn_mfma_f32_32x32x16_bf16(w0v[s2], hbv[s2], a0, 0, 0, 0);
                    a1 = __builtin_amdgcn_mfma_f32_32x32x16_bf16(w1v[s2], hbv[s2], a1, 0, 0, 0);
                }
                if (kvsel == 0) {
                    float ss = 0.f;
#pragma unroll
                    for (int i = 0; i < 16; ++i) ss += a0[i] * a0[i] + a1[i] * a1[i];
                    const float rs = rsqrtf(half_sum(ss) * (1.f / 64.f) + EPS);
#pragma unroll
                    for (int i = 0; i < 16; ++i) { a0[i] *= rs * args.in[I_KG][crow(i, hi)]; a1[i] *= rs * args.in[I_KG][32 + crow(i, hi)]; }
                }
                const float keep = ((row & (NCMPP - 1)) == NCMP) ? 0.f : 1.f;
                bf16* orow = KCMP + (size_t)row * 64 + 4 * hi;
#pragma unroll
                for (int q4 = 0; q4 < 4; ++q4) {
                    u32x2 w0; w0.x = cvtpk(a0[4 * q4] * keep, a0[4 * q4 + 1] * keep); w0.y = cvtpk(a0[4 * q4 + 2] * keep, a0[4 * q4 + 3] * keep);
                    u32x2 w1; w1.x = cvtpk(a1[4 * q4] * keep, a1[4 * q4 + 1] * keep); w1.y = cvtpk(a1[4 * q4 + 2] * keep, a1[4 * q4 + 3] * keep);
                    *(u32x2*)(orow + 8 * q4) = w0; *(u32x2*)(orow + 32 + 8 * q4) = w1;
                }
            } else {
                float gmax = 0.f;
                { const f32x4 gk = *(const f32x4*)(args.in[I_MKG] + lane_ * 4), gq = *(const f32x4*)(args.in[I_MQG] + lane_ * 4);
                  gmax = wave_max(fmaxf(fmaxf(fabsf(gk[0] * gq[0]), fabsf(gk[1] * gq[1])), fmaxf(fabsf(gk[2] * gq[2]), fabsf(gk[3] * gq[3])))); }
                const float mrefm = 16.f * gmax * LOG2E * 1.02f;
                bf16x8_t qfm[16];
                for (int u = bx - NU; u < BPC * MH * (SEQ / 256); u += G - NU) { const int bl = u >> 7, hm = (u >> 5) & 3, tb = u & 31;
                    const int un = u + (G - NU); const bf16* kbn = (un < BPC * MH * (SEQ / 256)) ? KM + (size_t)((ch * BPC + (un >> 7)) * MH + ((un >> 5) & 3)) * NMEM * MHD : nullptr;
                    const bf16* qmn = (kbn != nullptr) ? QM + (size_t)((un >> 7) * SEQ + (un & 31) * 256) * DM + ((un >> 5) & 3) * MHD : nullptr;
                    mem_unit_lds(QM, KM, VM, OMEM, lds, bl * SEQ + tb * 256, ch * BPC + bl, hm, mrefm, wave, u == bx - NU, kbn, qfm, qmn); }
            }
        }
        xcd_barrier(bar);
        {
            NsaU U; U.qn = QN; U.kv = KV; U.kcmp = KCMP; U.gates = GATES; U.onsa = QN; U.relb = args.in[I_RELB]; U.kbound = 0.f;
            const int v = (G % 8 == 0) ? (bx % 8) * (G / 8) + bx / 8 : bx;
            for (int uu = v; uu < BPC * NG * 32; uu += G) {
                const int bg = uu >> 5, s5 = uu & 31;
                { LAS float* lut = (LAS float*)(lds + NL_LUT); const int g = bg & 3;
                  const int tid = wave * 64 + lane_fresh();
                  __syncthreads();
                  for (int i = tid; i < 4 * 129; i += 512) { const int rr = i / 129, n = i - rr * 129; lut[rr * LUTS + 1 + n] = args.in[I_RELB][rel_bucket(n) * NH + g * 4 + rr] * LOG2E; }
                  if (tid < 4) { float bm = -1e30f; for (int b_ = 0; b_ < 32; ++b_) bm = fmaxf(bm, args.in[I_RELB][b_ * NH + g * 4 + tid] * LOG2E); lut[tid * LUTS + 130] = bm; lut[tid * LUTS] = -1e30f;  }
                  if (tid < 64) { const float kmax_ = wave_max(fabsf(args.in[I_KG][tid])); if (tid == 0) lut[131] = 8.f * kmax_ * 1.01f; }
                  LAS float* rl = (LAS float*)(lds + NL_RLUT);
                  for (int i = tid; i < 4 * 256; i += 512) { const int rr = i >> 8, xx = i & 255, dist = 191 - xx;
                      rl[rr * RLS + xx] = dist < 0 ? -1e30f : args.in[I_RELB][rel_bucket(dist > 128 ? 128 : dist) * NH + g * 4 + rr] * LOG2E; }
                  __syncthreads(); }
#pragma unroll 1
                for (int k = 0; k < 4; ++k) { const int qb = (k == 0) ? s5 : (k == 1) ? 63 - s5 : (k == 2) ? 64 + s5 : 127 - s5;
                    nsa_unit(U, lds, bg >> 2, bg & 3, qb, wave); }
            }
        }
        xcd_barrier(bar);
        {
            const float* cw = args.in[I_CONVW]; const float* cb = args.in[I_CONVB];
            const int tid_ = wave * 64 + lane_fresh();
            for (size_t idx = (size_t)bx * 512 + tid_; idx < (size_t)TC * 128; idx += (size_t)G * 512) {
                const int tl = (int)(idx >> 7), c0 = (int)(idx & 127) * 8, s = tl & (SEQ - 1);
                float u0[8], u1[8], u2[8], gbv[8], gn[8], gc[8], gm[8], on[8], om[8];
                unpack8(*(const u32x4*)(UB + (size_t)tl * DM + c0), u2);
                if (s >= 1) unpack8(*(const u32x4*)(UB + (size_t)(tl - 1) * DM + c0), u1); else { for (int e = 0; e < 8; ++e) u1[e] = 0.f; }
                if (s >= 2) unpack8(*(const u32x4*)(UB + (size_t)(tl - 2) * DM + c0), u0); else { for (int e = 0; e < 8; ++e) u0[e] = 0.f; }
                unpack8(*(const u32x4*)(GB + (size_t)tl * DM + c0), gbv);
                { const u32x2 a8 = *(const u32x2*)(MG + (size_t)tl * 3072 + c0), b8 = *(const u32x2*)(MG + (size_t)tl * 3072 + 1024 + c0), c8 = *(const u32x2*)(MG + (size_t)tl * 3072 + 2048 + c0);
#pragma unroll
                  for (int e = 0; e < 4; ++e) { const float k255 = 1.f / 255.f;
                      gn[e] = (float)((a8.x >> (8 * e)) & 255u) * k255; gn[4 + e] = (float)((a8.y >> (8 * e)) & 255u) * k255;
                      gc[e] = (float)((b8.x >> (8 * e)) & 255u) * k255; gc[4 + e] = (float)((b8.y >> (8 * e)) & 255u) * k255;
                      gm[e] = (float)((c8.x >> (8 * e)) & 255u) * k255; gm[4 + e] = (float)((c8.y >> (8 * e)) & 255u) * k255; } }
                unpack8(*(const u32x4*)(QN + (size_t)tl * DM + c0), on);
                unpack8(*(const u32x4*)(OMEM + (size_t)tl * DM + c0), om);
                float o[8];
#pragma unroll
                for (int e = 0; e < 8; ++e) { const int c = c0 + e;
                    const float y = cw[c] * u0[e] + cw[DM + c] * u1[e] + cw[2 * DM + c] * u2[e] + cb[c];
                    o[e] = gn[e] * on[e] + gc[e] * (gbv[e] * y) + gm[e] * om[e]; }
                u32x4 w; w.x = pk2(o[0], o[1]); w.y = pk2(o[2], o[3]); w.z = pk2(o[4], o[5]); w.w = pk2(o[6], o[7]);
                *(u32x4*)(MERGED + (size_t)(tok0 + tl) * DM + c0) = w;
            }
        }
        xcd_barrier(bar);
    }

    {
        pg8::Gemm g{MERGED, WOT, T, DM, DM, DM}; pg8::StaticOrder S; S.init(T, DM, G, bx);
        EpiResidB<false> E{XB, 1.0f, ssq2, nullptr};
        pg8::gemm_phase<EpiResidB<false>, pg8::StaticOrder, true, true>(lds, g, S, E, wave);
    }
    xcd_barrier(bar);
    {
        pg8::Gemm g{XB, W3T, T, FF2, DM, DM}; pg8::StaticOrder S; S.init(T, FF2, G, bx);
        EpiSwiglu E{ACT, ssq2};
        pg8::gemm_phase<EpiSwiglu, pg8::StaticOrder, true, true>(lds, g, S, E, wave);
    }
    xcd_barrier(bar);
    {
        pg8::Gemm g{ACT, W4T, T, DM, FF, FF}; pg8::StaticOrder S; S.init(T, DM, G, bx);
        EpiResidB<true> E{XB, 0.5f, nullptr, out};
        pg8::gemm_phase<EpiResidB<true>, pg8::StaticOrder, true, true>(lds, g, S, E, wave);
    }
}

extern "C" void kernel_launch(void* const* d_in, const int* in_sizes, int n_in, void* d_out, int out_size, void* d_ws, size_t ws_size, hipStream_t stream) {
    static int grid = 0;
    if (grid == 0) {
        if (n_in != 26 || in_sizes[0] != T * DM || out_size != T * DM || ws_size < WS_END) {
            fprintf(stderr, "kernel_launch: unexpected shapes (n_in %d, in0 %d, out %d, ws %zu < %zu); nothing launched\n", n_in, n_in > 0 ? in_sizes[0] : -1, out_size, ws_size, (size_t)WS_END);
            grid = -1; return; }
        int dev = 0, cus = 0, per_cu = 0;
        (void)hipGetDevice(&dev); (void)hipDeviceGetAttribute(&cus, hipDeviceAttributeMultiprocessorCount, dev);
        (void)hipFuncSetAttribute((const void*)fwd_megakernel, hipFuncAttributeMaxDynamicSharedMemorySize, LDS_BYTES);
        (void)hipOccupancyMaxActiveBlocksPerMultiprocessor(&per_cu, (const void*)fwd_megakernel, 512, LDS_BYTES);
        if (per_cu < 1) { fprintf(stderr, "kernel_launch: occupancy query says %d blocks per CU\n", per_cu); per_cu = 1; }
        (void)hipGetLastError();
        grid = cus;
        if (grid != 256) fprintf(stderr, "kernel_launch: note: %d CUs\n", grid);
    }
    if (grid < 0) return;
    Args a{};
    for (int i = 0; i < 26; ++i) a.in[i] = (const float*)d_in[i];
    a.out = (float*)d_out; a.ws = (unsigned char*)d_ws;
    if (hipMemsetAsync((char*)d_ws + WS_CTL, 0, 16384, stream) != hipSuccess) { fprintf(stderr, "kernel_launch: hipMemsetAsync failed\n"); return; }
    hipLaunchKernelGGL(fwd_megakernel, dim3(grid), dim3(512), LDS_BYTES, stream, a);
    const hipError_t e = hipPeekAtLastError();
    if (e != hipSuccess) fprintf(stderr, "kernel_launch: launch failed: %s (grid %d)\n", hipGetErrorString(e), grid);
}
```

```cpp
#include <hip/hip_runtime.h>
#include <cstdio>
#include <cstdint>

__device__ __forceinline__ int lane_fresh() { int l; asm volatile("v_mbcnt_lo_u32_b32 %0, -1, 0\n\tv_mbcnt_hi_u32_b32 %0, -1, %0" : "=v"(l)); return l; }
namespace pg8 {
#define PG8_LAS __attribute__((address_space(3)))
typedef unsigned short bf16_t;
typedef short bf16x8 __attribute__((ext_vector_type(8)));
typedef float f32x4 __attribute__((ext_vector_type(4)));
typedef unsigned u32x4 __attribute__((ext_vector_type(4)));
typedef unsigned u32x2 __attribute__((ext_vector_type(2)));
constexpr int BM = 256, BK = 64, HALF = 128, HTB = HALF * BK * 2, STAGE_BYTES = 8 * HTB, NXCD = 8, WGM = 8;

__host__ __device__ __forceinline__ int lds_byte(int r, int c) { const int st = (r >> 4) * 2 + (c >> 5), rr = r & 15, cc = c & 31, ob = rr * 64 + cc * 2; return st * 1024 + (ob ^ (((ob >> 9) & 1) << 5)); }
__host__ __device__ __forceinline__ void stage_rc(int b, int& R, int& C) { const int st = b / 1024, sb = b % 1024, swz = sb ^ (((sb >> 9) & 1) << 5); R = (st >> 1) * 16 + swz / 64; C = (st & 1) * 32 + (swz % 64) / 2; }
__host__ __device__ __forceinline__ int perm32(int rho) { const int n = rho >> 4, i = rho & 15; return 8 * (i >> 2) + 4 * n + (i & 3); }

struct Unit { int pm, pn; };
struct Gemm { const bf16_t* A; const bf16_t* Bt; int M, N, K, lda; };

struct StaticOrder {
    int nM, nN, nwg, G, c;
    __host__ __device__ void init(int M, int N, int G_, int c_) { nM = M / BM; nN = N / BM; nwg = nM * nN; G = G_; c = c_; }
    __host__ __device__ bool next(int i, Unit& u) const {
        const long L = (long)i * G + c; if (L >= nwg) return false;
        int wgid = (int)L; { const int q = nwg / NXCD, r = nwg % NXCD, xcd = wgid % NXCD, off = wgid / NXCD; wgid = (xcd < r ? xcd * (q + 1) : r * (q + 1) + (xcd - r) * q) + off; }
        const int nig = WGM * nN, gid = wgid / nig, fm = gid * WGM, gsz = (nM - fm) < WGM ? (nM - fm) : WGM;
        u.pm = fm + ((wgid % nig) % gsz); u.pn = (wgid % nig) / gsz; return true;
    }
    __device__ __forceinline__ void a_ready(const Unit&) const {}
    __device__ __forceinline__ void done(const Unit&) const {}
};
struct PairOrder {
    int nu, per, G, c;
    __device__ bool next(int i, Unit& u) const { const int L = i * G + c; if (L >= nu) return false; u.pm = L; u.pn = L / per; return true; }
    __device__ __forceinline__ void a_ready(const Unit&) const {}
    __device__ __forceinline__ void done(const Unit&) const {}
};

__device__ __forceinline__ unsigned cvt_pk_bf16(float lo, float hi) { unsigned r; asm volatile("v_cvt_pk_bf16_f32 %0, %1, %2" : "=v"(r) : "v"(lo), "v"(hi)); return r; }

template <class Epi, class Sched, bool ALIGN_EPI = false, bool SP2 = false>
__device__ __forceinline__ void gemm_phase(PG8_LAS unsigned char* lds, const Gemm g, const Sched& S, const Epi& E, const int wv) {
    const int tid = wv * 64 + lane_fresh();
    const int wid = __builtin_amdgcn_readfirstlane(tid >> 6), lane = tid & 63, wr = wid >> 2, wc = wid & 3, fr = lane & 15, fq = lane >> 4;
    const int K = g.K, nt = K / BK;
    unsigned voffA[2], voffB[2];
#pragma unroll
    for (int i = 0; i < 2; ++i) { int R, C; stage_rc(tid * 16 + i * 8192, R, C); const int Rb = Epi::PERM ? ((R & ~31) + perm32(R & 31)) : R;
        voffA[i] = (unsigned)(R * g.lda + C) * 2u; voffB[i] = (unsigned)(Rb * K + C) * 2u; }
    const size_t kstep = (size_t)(BK * 2);
    const size_t hstepA = (size_t)HALF * g.lda * 2, hstepB = (size_t)HALF * K * 2;
    const size_t tstepA = 2 * hstepA, tstepB = 2 * hstepB;
    const unsigned ldsw = (unsigned)wid * 1024u;
    const int aoff = lds_byte(wr * 64 + fr, fq * 8), boff = lds_byte(wc * 32 + fr, fq * 8);
#define PG8_SA(b, h) (((b) * 2 + (h)) * HTB)
#define PG8_SB(b, h) ((4 + (b) * 2 + (h)) * HTB)
#define PG8_STAGE(bufoff, gbase, voff) do { _Pragma("unroll") for (int _i = 0; _i < 2; ++_i) \
        __builtin_amdgcn_global_load_lds((const unsigned*)((const char*)(gbase) + (voff)[_i]), (PG8_LAS unsigned*)(lds + (bufoff) + ldsw + _i * 8192), 16, 0, 0); } while (0)
#define PG8_LDA(dst, b, h) do { _Pragma("unroll") for (int m = 0; m < 4; ++m) _Pragma("unroll") for (int k = 0; k < 2; ++k) dst[m][k] = *(const PG8_LAS bf16x8*)(lds + PG8_SA(b, h) + aoff + m * 2048 + k * 1024); } while (0)
#define PG8_LDB(dst, b, h) do { _Pragma("unroll") for (int n = 0; n < 2; ++n) _Pragma("unroll") for (int k = 0; k < 2; ++k) dst[n][k] = *(const PG8_LAS bf16x8*)(lds + PG8_SB(b, h) + boff + n * 2048 + k * 1024); } while (0)
#define PG8_MMA(ai, bj, At, Bt) do { __builtin_amdgcn_s_setprio(1); _Pragma("unroll") for (int m = 0; m < 4; ++m) _Pragma("unroll") for (int n = 0; n < 2; ++n) _Pragma("unroll") for (int k = 0; k < 2; ++k) \
        acc[ai][bj][m][n] = __builtin_amdgcn_mfma_f32_16x16x32_bf16(Bt[n][k], At[m][k], acc[ai][bj][m][n], 0, 0, 0); __builtin_amdgcn_s_setprio(0); } while (0)
#define PG8_WAIT_V(n) asm volatile("s_waitcnt vmcnt(" #n ")" ::: "memory")
#define PG8_WAIT_L(n) asm volatile("s_waitcnt lgkmcnt(" #n ")" ::: "memory")
#define PG8_BAR __builtin_amdgcn_s_barrier()
#define PG8_SCHED __builtin_amdgcn_sched_barrier(0)
    Unit cur, nxt; int ui = 0;
    if (!S.next(0, cur)) return;
    f32x4 acc[2][2][4][2];
#pragma unroll
    for (int a = 0; a < 2; ++a)
#pragma unroll
        for (int b = 0; b < 2; ++b)
#pragma unroll
            for (int m = 0; m < 4; ++m)
#pragma unroll
                for (int n = 0; n < 2; ++n) acc[a][b][m][n] = (f32x4){0.f, 0.f, 0.f, 0.f};
    bf16x8 At[4][2], B0[2][2], B1[2][2];
    const char* cA = (const char*)g.A + (size_t)cur.pm * tstepA; const char* cB = (const char*)g.Bt + (size_t)cur.pn * tstepB;
    S.a_ready(cur);
    if constexpr (SP2) {
        PG8_STAGE(PG8_SB(0, 0), cB, voffB); PG8_STAGE(PG8_SB(0, 1), cB + hstepB, voffB); PG8_STAGE(PG8_SA(0, 0), cA, voffA); PG8_STAGE(PG8_SA(0, 1), cA + hstepA, voffA);
        if (wr == 1) PG8_BAR;
        PG8_WAIT_V(2); PG8_BAR;
        PG8_STAGE(PG8_SB(1, 0), cB + kstep, voffB); PG8_STAGE(PG8_SA(1, 0), cA + kstep, voffA); PG8_STAGE(PG8_SB(1, 1), cB + hstepB + kstep, voffB);
        PG8_WAIT_V(6); PG8_BAR;
    } else {
        PG8_STAGE(PG8_SB(0, 0), cB, voffB); PG8_STAGE(PG8_SA(0, 0), cA, voffA); PG8_STAGE(PG8_SB(0, 1), cB + hstepB, voffB); PG8_STAGE(PG8_SA(0, 1), cA + hstepA, voffA);
        if (wr == 1) PG8_BAR;
        PG8_WAIT_V(4); PG8_BAR;
        PG8_STAGE(PG8_SB(1, 0), cB + kstep, voffB); PG8_STAGE(PG8_SA(1, 0), cA + kstep, voffA); PG8_STAGE(PG8_SB(1, 1), cB + hstepB + kstep, voffB);
        PG8_WAIT_V(6); PG8_BAR;
    }
    for (;;) {
        const bool has_next = S.next(ui + 1, nxt);
        const char* nA = has_next ? (const char*)g.A + (size_t)nxt.pm * tstepA : cA; const char* nB = has_next ? (const char*)g.Bt + (size_t)nxt.pn * tstepB : cB;
        for (int t = 0; t < nt; t += 2) {
            const bool last = (t == nt - 2);
            const char* a1 = cA + (size_t)(t + 1) * kstep;
            const char* a2 = last ? nA : cA + (size_t)(t + 2) * kstep; const char* b2 = last ? nB : cB + (size_t)(t + 2) * kstep;
            const char* a3 = a2 + kstep; const char* b3 = b2 + kstep;
            if (last && has_next) S.a_ready(nxt);
            if constexpr (SP2) {
            PG8_LDB(B0, 0, 0); PG8_LDB(B1, 0, 1); PG8_SCHED; PG8_LDA(At, 0, 0); PG8_STAGE(PG8_SA(1, 1), a1 + hstepA, voffA);
            PG8_WAIT_V(8); PG8_WAIT_L(0); PG8_BAR; PG8_MMA(0, 0, At, B0); PG8_MMA(0, 1, At, B1); PG8_BAR; PG8_SCHED;
            PG8_LDA(At, 0, 1); PG8_STAGE(PG8_SB(0, 0), b2, voffB); PG8_STAGE(PG8_SB(0, 1), b2 + hstepB, voffB); PG8_STAGE(PG8_SA(0, 0), a2, voffA);
            PG8_WAIT_V(8); PG8_WAIT_L(0); PG8_BAR; PG8_MMA(1, 0, At, B0); PG8_MMA(1, 1, At, B1); PG8_BAR; PG8_SCHED;
            PG8_LDB(B0, 1, 0); PG8_LDB(B1, 1, 1); PG8_SCHED; PG8_LDA(At, 1, 0); PG8_STAGE(PG8_SA(0, 1), a2 + hstepA, voffA);
            PG8_WAIT_V(8); PG8_WAIT_L(0); PG8_BAR; PG8_MMA(0, 0, At, B0); PG8_MMA(0, 1, At, B1); PG8_BAR; PG8_SCHED;
            PG8_LDA(At, 1, 1); PG8_STAGE(PG8_SB(1, 0), b3, voffB); PG8_STAGE(PG8_SB(1, 1), b3 + hstepB, voffB); PG8_STAGE(PG8_SA(1, 0), a3, voffA);
            PG8_WAIT_V(8); PG8_WAIT_L(0); PG8_BAR; PG8_MMA(1, 0, At, B0); PG8_MMA(1, 1, At, B1); PG8_BAR; PG8_SCHED;
            } else {
            PG8_LDB(B0, 0, 0); PG8_SCHED; PG8_LDA(At, 0, 0); PG8_STAGE(PG8_SA(1, 1), a1 + hstepA, voffA);
            PG8_WAIT_L(8); PG8_BAR; PG8_WAIT_L(0); PG8_MMA(0, 0, At, B0); PG8_BAR; PG8_SCHED;
            PG8_LDB(B1, 0, 1); PG8_STAGE(PG8_SB(0, 0), b2, voffB);
            PG8_BAR; PG8_WAIT_L(0); PG8_MMA(0, 1, At, B1); PG8_BAR;
            PG8_LDA(At, 0, 1); PG8_STAGE(PG8_SA(0, 0), a2, voffA);
            PG8_BAR; PG8_WAIT_L(0); PG8_MMA(1, 0, At, B0); PG8_BAR; PG8_SCHED;
            PG8_STAGE(PG8_SB(0, 1), b2 + hstepB, voffB);
            PG8_WAIT_V(6); PG8_BAR; PG8_MMA(1, 1, At, B1); PG8_BAR;
            PG8_LDB(B0, 1, 0); PG8_SCHED; PG8_LDA(At, 1, 0); PG8_STAGE(PG8_SA(0, 1), a2 + hstepA, voffA);
            PG8_WAIT_L(8); PG8_BAR; PG8_WAIT_L(0); PG8_MMA(0, 0, At, B0); PG8_BAR; PG8_SCHED;
            PG8_LDB(B1, 1, 1); PG8_STAGE(PG8_SB(1, 0), b3, voffB);
            PG8_BAR; PG8_WAIT_L(0); PG8_MMA(0, 1, At, B1); PG8_BAR;
            PG8_LDA(At, 1, 1); PG8_STAGE(PG8_SA(1, 0), a3, voffA);
            PG8_BAR; PG8_WAIT_L(0); PG8_MMA(1, 0, At, B0); PG8_BAR; PG8_SCHED;
            PG8_STAGE(PG8_SB(1, 1), b3 + hstepB, voffB);
            PG8_WAIT_V(6); PG8_BAR; PG8_MMA(1, 1, At, B1); PG8_BAR;
            }
        }
        if constexpr (ALIGN_EPI) { if (wr == 0) PG8_BAR; }
        E(acc, cur, wr, wc, fr, fq); S.done(cur);
        if (!has_next) break;
#pragma unroll
        for (int a = 0; a < 2; ++a)
#pragma unroll
            for (int b = 0; b < 2; ++b)
#pragma unroll
                for (int m = 0; m < 4; ++m)
#pragma unroll
                    for (int n = 0; n < 2; ++n) acc[a][b][m][n] = (f32x4){0.f, 0.f, 0.f, 0.f};
        cur = nxt; cA = nA; cB = nB; ++ui;
        if constexpr (ALIGN_EPI) { if (wr == 1) PG8_BAR; }
    }
    PG8_WAIT_V(0);
    if constexpr (!ALIGN_EPI) { if (wr == 0) PG8_BAR; }
    PG8_BAR;
#undef PG8_SA
#undef PG8_SB
#undef PG8_STAGE
#undef PG8_LDA
#undef PG8_LDB
#undef PG8_MMA
#undef PG8_WAIT_V
#undef PG8_WAIT_L
#undef PG8_BAR
#undef PG8_SCHED
}
}

typedef unsigned short bf16;
typedef float f32x4 __attribute__((ext_vector_type(4)));
typedef unsigned u32x4 __attribute__((ext_vector_type(4)));
typedef unsigned u32x2 __attribute__((ext_vector_type(2)));
#define LAS __attribute__((address_space(3)))

constexpr int DM = 1024, NB = 4, SEQ = 8192, T = NB * SEQ;
constexpr int NH = 16, HD = 64, NG = 4, HPG = 4;
constexpr int NCMP = 511, NCMPP = 512;
constexpr int NSELB = 128, NTOP = 16, WIN = 512;
constexpr int NMEM = 256, MH = 4, MHD = 256;
constexpr int FF = 2816, FF2 = 5632;
constexpr int INW = 9776;
constexpr int NT_IN = 39, INWP = NT_IN * 256;
constexpr float EPS = 1e-6f;
constexpr float LOG2E = 1.4426950408889634f;
constexpr int NCHUNK = 1, TC = T / NCHUNK, BPC = NB / NCHUNK;
constexpr int C_Q = 0, C_KV = 1024, C_NG = 2560, C_GB = 2608, C_GC = 3632, C_XI = 4656, C_QM = 5680, C_MG = 6704;
constexpr int TQ0 = 0, TKV0 = 4, TNG = 10, TCU0 = 11, TGB0 = 19, TQM0 = 23, TMG0 = 27;

constexpr size_t MiB = 1u << 20;
constexpr size_t WS_CTL = 0;
constexpr size_t OFF_SSQ0 = 64 * 1024;
constexpr size_t OFF_SSQ1 = OFF_SSQ0 + (size_t)T * 4;
constexpr size_t OFF_SSQ2 = OFF_SSQ1 + (size_t)T * 4;
constexpr size_t OFF_BIAS1 = OFF_SSQ2 + (size_t)T * 4;
constexpr size_t OFF_WC2T = OFF_BIAS1 + 512 * 4;
constexpr size_t WS_SMALL_END = 1 * MiB;
static_assert(OFF_WC2T + 2 * 64 * 256 * 2 <= WS_SMALL_END, "small region");
constexpr size_t WS_W1T = 1 * MiB;
constexpr size_t WS_W2T = WS_W1T + (size_t)FF2 * DM * 2;
constexpr size_t WS_WINT = WS_W2T + (size_t)DM * FF * 2;
constexpr size_t WS_WOT = WS_WINT + (size_t)INWP * DM * 2;
constexpr size_t WS_W3T = WS_WOT + (size_t)DM * DM * 2;
constexpr size_t WS_W4T = WS_W3T + (size_t)FF2 * DM * 2;
constexpr size_t WS_WC1T = WS_W4T + (size_t)DM * FF * 2;
constexpr size_t WS_WMKVT = WS_WC1T + (size_t)512 * 2048 * 2;
constexpr size_t WS_MEMN = WS_WMKVT + (size_t)2048 * 1024 * 2;
constexpr size_t WS_KM = WS_MEMN + (size_t)1024 * 1024 * 2;
constexpr size_t WS_VM = WS_KM + (size_t)1024 * 1024 * 2;
constexpr size_t WS_KCMP = WS_VM + (size_t)1024 * 1024 * 2;
constexpr size_t WS_HID = WS_KCMP + (size_t)2 * BPC * NG * NCMPP * 64 * 2;
constexpr size_t WS_WEND = WS_HID + (size_t)2 * BPC * NG * NCMPP * 256 * 2;
static_assert(WS_WEND <= 84 * MiB, "weights region");
constexpr size_t WS_A = 84 * MiB;
constexpr size_t WS_MG = WS_A;
constexpr size_t WS_U = WS_MG + (size_t)TC * 3072;
constexpr size_t WS_GATES = WS_U + (size_t)TC * 1024 * 2;
static_assert(WS_GATES + (size_t)TC * 48 * 4 <= WS_A + 192 * MiB && (size_t)T * FF * 2 <= 192 * MiB, "region A");
constexpr size_t WS_XB = WS_A + 192 * MiB;
constexpr size_t WS_KV = WS_XB + 64 * MiB;
constexpr size_t KVSZ = (size_t)BPC * NG * SEQ * 64;
constexpr size_t WS_GB = WS_KV + 6 * KVSZ * 2 + 64 * 1024;
constexpr size_t WS_MERGED = WS_GB;
constexpr size_t WS_END = WS_GB + (size_t)T * 1024 * 2;
static_assert(WS_END <= 512 * MiB, "workspace map must fit 512 MiB");

constexpr int RING_BYTES = 131072;
constexpr int LDS_BYTES = 147456;

__device__ __forceinline__ float bf2f(unsigned short v) { return __uint_as_float((unsigned)v << 16); }
__device__ __forceinline__ unsigned f2bf(float f) { unsigned u = __float_as_uint(f); return (u + 0x7fffu + ((u >> 16) & 1u)) >> 16; }
typedef __bf16 bf16x2v_t __attribute__((ext_vector_type(2))); typedef float f32x2v_t __attribute__((ext_vector_type(2)));
__device__ __forceinline__ unsigned pk2(float lo, float hi) { return __builtin_bit_cast(unsigned, __builtin_convertvector((f32x2v_t){lo, hi}, bf16x2v_t)); }
template <int CTRL> __device__ __forceinline__ float dppf(float x) { return __builtin_bit_cast(float, __builtin_amdgcn_mov_dpp(__builtin_bit_cast(int, x), CTRL, 0xf, 0xf, true)); }
__device__ __forceinline__ float xor16f(float x) { return __builtin_bit_cast(float, __builtin_amdgcn_ds_swizzle(__builtin_bit_cast(int, x), 0x401F)); }
__device__ __forceinline__ float half_lo(float x, float& hi_) { auto rr = __builtin_amdgcn_permlane32_swap(__float_as_uint(x), __float_as_uint(x), false, false); hi_ = __uint_as_float(rr[1]); return __uint_as_float(rr[0]); }
__device__ __forceinline__ float wave_sum(float v) {
    v += dppf<0xB1>(v); v += dppf<0x4E>(v); v += dppf<0x141>(v); v += dppf<0x140>(v); v += xor16f(v);
    float h; const float l = half_lo(v, h); return l + h;
}
__device__ __forceinline__ float wave_max(float v) {
    v = fmaxf(v, dppf<0xB1>(v)); v = fmaxf(v, dppf<0x4E>(v)); v = fmaxf(v, dppf<0x141>(v)); v = fmaxf(v, dppf<0x140>(v)); v = fmaxf(v, xor16f(v));
    float h; const float l = half_lo(v, h); return fmaxf(l, h);
}
__device__ __forceinline__ float fast_exp2(float x) { return __builtin_amdgcn_exp2f(x); }
__device__ __forceinline__ float fast_rcp(float x) { return __builtin_amdgcn_rcpf(x); }
__device__ __forceinline__ float sigmoidf_(float v) { return fast_rcp(1.f + fast_exp2(-v * LOG2E)); }
__device__ __forceinline__ float siluf_(float v) { return v * sigmoidf_(v); }
__device__ __forceinline__ void unpack8(const u32x4 w, float* f) {
    f[0] = __uint_as_float(w.x << 16); f[1] = __uint_as_float(w.x & 0xffff0000u);
    f[2] = __uint_as_float(w.y << 16); f[3] = __uint_as_float(w.y & 0xffff0000u);
    f[4] = __uint_as_float(w.z << 16); f[5] = __uint_as_float(w.z & 0xffff0000u);
    f[6] = __uint_as_float(w.w << 16); f[7] = __uint_as_float(w.w & 0xffff0000u);
}

struct Args {
    const float* in[26];
    float* out;
    unsigned char* ws;
};
enum { I_X = 0, I_MEM, I_F1G, I_F1WI, I_F1WO, I_MIXG, I_WIN, I_QG, I_KG, I_PEK, I_W1K, I_W2K, I_PEV, I_W1V, I_W2V, I_CONVW, I_CONVB,
       I_MEMG, I_WMKV, I_MQG, I_MKG, I_WOUT, I_F2G, I_F2WI, I_F2WO, I_RELB };

__device__ __forceinline__ int src_swiglu(int n) { return ((n & 128) ? FF : 0) + 128 * (n >> 8) + (n & 127); }
__device__ __forceinline__ int src_win(int n) {
    const int pn = n >> 8, c = n & 255;
    if (pn < TKV0) return C_Q + 64 * (4 * pn + ((c >> 5) & 3)) + 32 * (c >> 7) + (c & 31);
    if (pn < TNG) return C_KV + 256 * (pn - TKV0) + 64 * ((c >> 5) & 3) + 32 * (c >> 7) + (c & 31);
    if (pn == TNG) return c < 48 ? C_NG + c : -1;
    if (pn < TGB0) return ((c & 128) ? C_XI : C_GC) + 128 * (pn - TCU0) + (c & 127);
    if (pn < TQM0) return C_GB + 256 * (pn - TGB0) + c;
    if (pn < TMG0) return C_QM + 256 * (pn - TQM0) + c;
    return C_MG + 256 * (pn - TMG0) + c;
}

template <int MAP>
__device__ __forceinline__ void transpose_item64(const float* W, int K, int N, const float* gk, bf16* WT, LAS float* scr, int item, int lane) {
    const int kblocks = K / 64, nb = item / kblocks, kb = item % kblocks, k0 = 64 * kb, n0 = 64 * nb;
    const int nq = (lane & 15) * 4, kr = lane >> 4, n = n0 + nq;
    const int src = (MAP == 0) ? n : (MAP == 1) ? src_swiglu(n) : src_win(n);
    f32x4 v[16];
#pragma unroll
    for (int i = 0; i < 16; ++i) { const int kk = 4 * i + kr; v[i] = (src >= 0) ? __builtin_nontemporal_load((const f32x4*)(W + (size_t)(k0 + kk) * N + src)) : (f32x4){0.f, 0.f, 0.f, 0.f}; }
#pragma unroll
    for (int i = 0; i < 16; ++i) { const int kk = 4 * i + kr; const float g = gk ? gk[k0 + kk] : 1.f;
        LAS float* d = scr + kk * 65 + nq; d[0] = v[i][0] * g; d[1] = v[i][1] * g; d[2] = v[i][2] * g; d[3] = v[i][3] * g; }
    asm volatile("s_waitcnt lgkmcnt(0)" ::: "memory");
    const int c = lane & 7;
#pragma unroll
    for (int j = 0; j < 8; ++j) { const int nn = (lane >> 3) + 8 * j; const LAS float* sp = scr + (8 * c) * 65 + nn;
        u32x4 o; o.x = pk2(sp[0 * 65], sp[1 * 65]); o.y = pk2(sp[2 * 65], sp[3 * 65]); o.z = pk2(sp[4 * 65], sp[5 * 65]); o.w = pk2(sp[6 * 65], sp[7 * 65]);
        *(u32x4*)(WT + (size_t)(n0 + nn) * K + k0 + 8 * c) = o; }
    asm volatile("s_waitcnt lgkmcnt(0)" ::: "memory");
}


struct EpiSwiglu {
    static constexpr bool PERM = true;
    bf16* act; const float* ssq;
    __device__ __forceinline__ void operator()(const f32x4 (&acc)[2][2][4][2], const pg8::Unit& u, int wr, int wc, int fr, int fq) const {
        float rsv[8];
#pragma unroll
        for (int i = 0; i < 8; ++i) rsv[i] = ssq[u.pm * 256 + (i >> 2) * 128 + wr * 64 + (i & 3) * 16 + fr];
#pragma unroll
        for (int ai = 0; ai < 2; ++ai)
#pragma unroll
            for (int m = 0; m < 4; ++m) {
                const int row = u.pm * 256 + ai * 128 + wr * 64 + m * 16 + fr;
                const float rs = rsqrtf(rsv[ai * 4 + m] * (1.f / DM) + EPS);
                float o[8];
#pragma unroll
                for (int n = 0; n < 2; ++n)
#pragma unroll
                    for (int e = 0; e < 4; ++e) { const float a = acc[ai][0][m][n][e] * rs, b = acc[ai][1][m][n][e] * rs; o[4 * n + e] = siluf_(a) * b; }
                u32x4 w; w.x = pk2(o[0], o[1]); w.y = pk2(o[2], o[3]); w.z = pk2(o[4], o[5]); w.w = pk2(o[6], o[7]);
                *(u32x4*)(act + (size_t)row * FF + u.pn * 128 + wc * 32 + fq * 8) = w;
            }
    }
};

template <bool LAST> struct EpiResidB {
    static constexpr bool PERM = true;
    bf16* xb; float alpha; float* ssq; float* out;
    __device__ __forceinline__ void operator()(const f32x4 (&acc)[2][2][4][2], const pg8::Unit& u, int wr, int wc, int fr, int fq) const {
        u32x4 bs[16];
#pragma unroll
        for (int i = 0; i < 16; ++i) { const int row = u.pm * 256 + (i >> 3) * 128 + wr * 64 + ((i >> 1) & 3) * 16 + fr;
            bs[i] = *(const u32x4*)(xb + (size_t)row * DM + u.pn * 256 + (i & 1) * 128 + wc * 32 + fq * 8); }
#pragma unroll
        for (int ai = 0; ai < 2; ++ai)
#pragma unroll
            for (int m = 0; m < 4; ++m) {
                const int row = u.pm * 256 + ai * 128 + wr * 64 + m * 16 + fr;
                float ss = 0.f;
#pragma unroll
                for (int bj = 0; bj < 2; ++bj) {
                    const size_t off = (size_t)row * DM + u.pn * 256 + bj * 128 + wc * 32 + fq * 8;
                    float b[8]; unpack8(bs[ai * 8 + m * 2 + bj], b);
                    float v[8];
#pragma unroll
                    for (int e = 0; e < 4; ++e) { v[e] = b[e] + alpha * acc[ai][bj][m][0][e]; v[4 + e] = b[4 + e] + alpha * acc[ai][bj][m][1][e]; }
                    if (LAST) { *(f32x4*)(out + off) = (f32x4){v[0], v[1], v[2], v[3]}; *(f32x4*)(out + off + 4) = (f32x4){v[4], v[5], v[6], v[7]}; }
                    else {
#pragma unroll
                        for (int e = 0; e < 8; ++e) ss += v[e] * v[e];
                        u32x4 w; w.x = pk2(v[0], v[1]); w.y = pk2(v[2], v[3]); w.z = pk2(v[4], v[5]); w.w = pk2(v[6], v[7]);
                        *(u32x4*)(xb + off) = w; }
                }
                if (!LAST) { ss += xor16f(ss); { float h_; const float l_ = half_lo(ss, h_); ss = l_ + h_; } if (fq == 0) atomicAdd(ssq + row, ss); }
            }
    }
};

struct EpiMemKV {
    static constexpr bool PERM = true;
    bf16* km; bf16* vm;
    __device__ __forceinline__ void operator()(const f32x4 (&acc)[2][2][4][2], const pg8::Unit& u, int wr, int wc, int fr, int fq) const {
        const int hm = u.pn & 3;
#pragma unroll
        for (int ai = 0; ai < 2; ++ai)
#pragma unroll
            for (int m = 0; m < 4; ++m) {
                const int row = u.pm * 256 + ai * 128 + wr * 64 + m * 16 + fr; const int b = row >> 8, mm = row & 255;
#pragma unroll
                for (int bj = 0; bj < 2; ++bj) {
                    const f32x4 v0 = acc[ai][bj][m][0], v1 = acc[ai][bj][m][1];
                    if (u.pn < 4) {
                        u32x4 w; w.x = pk2(v0[0], v0[1]); w.y = pk2(v0[2], v0[3]); w.z = pk2(v1[0], v1[1]); w.w = pk2(v1[2], v1[3]);
                        *(u32x4*)(km + ((size_t)(b * MH + hm) * NMEM + mm) * MHD + bj * 128 + wc * 32 + fq * 8) = w;
                    } else {
                        const int mp = (mm & ~12) | ((mm & 4) << 1) | ((mm & 8) >> 1);
                        bf16* vt = vm + ((size_t)(b * MH + hm) * MHD + bj * 128 + wc * 32 + fq * 8) * NMEM + mp;
#pragma unroll
                        for (int e = 0; e < 4; ++e) { vt[(size_t)e * NMEM] = (bf16)f2bf(v0[e]); vt[(size_t)(4 + e) * NMEM] = (bf16)f2bf(v1[e]); }
                    }
                }
            }
    }
};

struct EpiHid {
    static constexpr bool PERM = true;
    bf16* hid; const float* bias;
    __device__ __forceinline__ void operator()(const f32x4 (&acc)[2][2][4][2], const pg8::Unit& u, int wr, int wc, int fr, int fq) const {
#pragma unroll
        for (int bj = 0; bj < 2; ++bj) {
            const f32x4 b0 = *(const f32x4*)(bias + u.pn * 256 + bj * 128 + wc * 32 + fq * 8), b1 = *(const f32x4*)(bias + u.pn * 256 + bj * 128 + wc * 32 + fq * 8 + 4);
#pragma unroll
            for (int ai = 0; ai < 2; ++ai)
#pragma unroll
                for (int m = 0; m < 4; ++m) {
                    const int row = u.pm * 256 + ai * 128 + wr * 64 + m * 16 + fr;
                    float o[8];
#pragma unroll
                    for (int e = 0; e < 4; ++e) { o[e] = siluf_(acc[ai][bj][m][0][e] + b0[e]); o[4 + e] = siluf_(acc[ai][bj][m][1][e] + b1[e]); }
                    u32x4 w; w.x = pk2(o[0], o[1]); w.y = pk2(o[2], o[3]); w.z = pk2(o[4], o[5]); w.w = pk2(o[6], o[7]);
                    *(u32x4*)(hid + (size_t)row * 256 + bj * 128 + wc * 32 + fq * 8) = w;
                }
        }
    }
};

constexpr float QSCALE = 0.125f * LOG2E;

struct EpiMix {
    static constexpr bool PERM = true;
    const float* ssq;
    const float* qg; const float* kg;
    bf16* qn; bf16* kv; float* gates; bf16* u_; bf16* gb; bf16* qm; unsigned char* mg;
    __device__ __forceinline__ void operator()(const f32x4 (&acc)[2][2][4][2], const pg8::Unit& u, int wr, int wc, int fr, int fq) const {
        const int pn = u.pn;
        float gq[2][8];
        if (pn < TNG) {
            const float* gsrc = (pn < TKV0) ? qg : kg;
#pragma unroll
            for (int bj = 0; bj < 2; ++bj)
#pragma unroll
                for (int e = 0; e < 8; ++e) gq[bj][e] = gsrc[bj * 32 + fq * 8 + e];
        }
        float rsv[8];
#pragma unroll
        for (int i = 0; i < 8; ++i) rsv[i] = ssq[u.pm * 256 + (i >> 2) * 128 + wr * 64 + (i & 3) * 16 + fr];
#pragma unroll
        for (int ai = 0; ai < 2; ++ai)
#pragma unroll
            for (int m = 0; m < 4; ++m) {
                const int row = u.pm * 256 + ai * 128 + wr * 64 + m * 16 + fr;
                const float rs = rsqrtf(rsv[ai * 4 + m] * (1.f / DM) + EPS);
                float v[2][8];
#pragma unroll
                for (int bj = 0; bj < 2; ++bj)
#pragma unroll
                    for (int n = 0; n < 2; ++n)
#pragma unroll
                        for (int e = 0; e < 4; ++e) v[bj][4 * n + e] = acc[ai][bj][m][n][e] * rs;
                if (pn < TNG) {
                    const bool isq = pn < TKV0; const int kvi = pn - TKV0;
                    const bool donorm = isq || kvi == 2 || kvi == 4;
                    float ss = 0.f;
#pragma unroll
                    for (int bj = 0; bj < 2; ++bj)
#pragma unroll
                        for (int e = 0; e < 8; ++e) ss += v[bj][e] * v[bj][e];
                    ss += xor16f(ss); { float h_; const float l_ = half_lo(ss, h_); ss = l_ + h_; }
                    const float r2 = donorm ? rsqrtf(ss * (1.f / 64.f) + EPS) * (isq ? QSCALE : 1.f) : 1.f;
                    bf16* dst;
                    if (isq) dst = qn + (size_t)row * DM + (4 * pn + wc) * 64;
                    else { const int bl = row >> 13, s = row & (SEQ - 1); dst = kv + (size_t)kvi * KVSZ + ((size_t)(bl * NG + wc) * SEQ + s) * 64; }
#pragma unroll
                    for (int bj = 0; bj < 2; ++bj) {
                        float o[8];
#pragma unroll
                        for (int e = 0; e < 8; ++e) o[e] = donorm ? v[bj][e] * r2 * gq[bj][e] : v[bj][e];
                        u32x4 w; w.x = pk2(o[0], o[1]); w.y = pk2(o[2], o[3]); w.z = pk2(o[4], o[5]); w.w = pk2(o[6], o[7]);
                        *(u32x4*)(dst + bj * 32 + fq * 8) = w;
                    }
                } else if (pn == TNG) {
                    const int c0 = wc * 32 + fq * 8;
                    if (c0 < 48) {
                        f32x4 a, b;
#pragma unroll
                        for (int e = 0; e < 4; ++e) { a[e] = sigmoidf_(v[0][e]); b[e] = sigmoidf_(v[0][4 + e]); }
                        *(f32x4*)(gates + (size_t)row * 48 + c0) = a; *(f32x4*)(gates + (size_t)row * 48 + c0 + 4) = b;
                    }
                } else if (pn < TGB0) {
                    float o[8];
#pragma unroll
                    for (int e = 0; e < 8; ++e) o[e] = v[0][e] * v[1][e];
                    u32x4 w; w.x = pk2(o[0], o[1]); w.y = pk2(o[2], o[3]); w.z = pk2(o[4], o[5]); w.w = pk2(o[6], o[7]);
                    *(u32x4*)(u_ + (size_t)row * DM + (pn - TCU0) * 128 + wc * 32 + fq * 8) = w;
                } else {
                    if (pn < TMG0) {
                        bf16* dst = (pn < TQM0) ? gb + (size_t)row * DM + (pn - TGB0) * 256 : qm + (size_t)row * DM + (pn - TQM0) * 256;
#pragma unroll
                        for (int bj = 0; bj < 2; ++bj) {
                            u32x4 w; w.x = pk2(v[bj][0], v[bj][1]); w.y = pk2(v[bj][2], v[bj][3]); w.z = pk2(v[bj][4], v[bj][5]); w.w = pk2(v[bj][6], v[bj][7]);
                            *(u32x4*)(dst + bj * 128 + wc * 32 + fq * 8) = w;
                        }
                    } else {
                        unsigned char* dst = mg + (size_t)row * 3072 + (pn - TMG0) * 256;
#pragma unroll
                        for (int bj = 0; bj < 2; ++bj) {
                            unsigned q[8];
#pragma unroll
                            for (int e = 0; e < 8; ++e) q[e] = (unsigned)(sigmoidf_(v[bj][e]) * 255.f + 0.5f);
                            u32x2 w; w.x = q[0] | (q[1] << 8) | (q[2] << 16) | (q[3] << 24); w.y = q[4] | (q[5] << 8) | (q[6] << 16) | (q[7] << 24);
                            *(u32x2*)(dst + bj * 128 + wc * 32 + fq * 8) = w;
                        }
                    }
                }
            }
    }
};

__device__ __forceinline__ int rel_bucket(int n) {
    if (n < 16) return n < 0 ? 0 : n;
    if (n >= 128) return 31;
    const int b = 16 + (int)(__log2f((float)n * (1.f / 16.f)) * (16.f / 3.f));
    return b > 31 ? 31 : b;
}

typedef float f32x16 __attribute__((ext_vector_type(16)));
typedef short bf16x8_t __attribute__((ext_vector_type(8)));
typedef short v4i16_t __attribute__((ext_vector_type(4)));
typedef float f32x2_t __attribute__((ext_vector_type(2)));
typedef __bf16 bf16x2_t __attribute__((ext_vector_type(2)));
__device__ __forceinline__ unsigned cvtpk(float lo, float hi) { f32x2_t v = {lo, hi}; bf16x2_t b = __builtin_convertvector(v, bf16x2_t); return __builtin_bit_cast(unsigned, b); }
__device__ __forceinline__ int crow(int r, int hi) { return (r & 3) + 8 * (r >> 2) + 4 * hi; }
__device__ __forceinline__ unsigned cvtpk_c(float lo, float hi) { return __builtin_bit_cast(unsigned, __builtin_convertvector((f32x2v_t){lo, hi}, bf16x2v_t)); }
__device__ __forceinline__ float dpp_x1(float x) { return __builtin_bit_cast(float, __builtin_amdgcn_mov_dpp(__builtin_bit_cast(int, x), 0xB1, 0xf, 0xf, true)); }
__device__ __forceinline__ float dpp_x2(float x) { return __builtin_bit_cast(float, __builtin_amdgcn_mov_dpp(__builtin_bit_cast(int, x), 0x4E, 0xf, 0xf, true)); }
__device__ __forceinline__ float half_sum(float x) { auto rr = __builtin_amdgcn_permlane32_swap(__float_as_uint(x), __float_as_uint(x), false, false); return __uint_as_float(rr[0]) + __uint_as_float(rr[1]); }
__device__ __forceinline__ v4i16_t vtr(const LAS unsigned char* p) { return __builtin_amdgcn_ds_read_tr16_b64_v4i16((LAS v4i16_t*)p); }

__device__ __forceinline__ void glds16(const void* gsrc, unsigned lds_dst) { unsigned keep;
    asm volatile("s_mov_b32 %0, m0\n\ts_mov_b32 m0, %2\n\ts_nop 0\n\tglobal_load_lds_dwordx4 %1, off\n\ts_mov_b32 m0, %0" : "=&s"(keep) : "v"(gsrc), "s"(lds_dst) : "memory"); }
__device__ __forceinline__ void glds16s(const void* sbase, unsigned voff, unsigned lds_dst) { unsigned keep;
    asm volatile("s_mov_b32 %0, m0\n\ts_mov_b32 m0, %2\n\ts_nop 0\n\tglobal_load_lds_dwordx4 %1, %3\n\ts_mov_b32 m0, %0" : "=&s"(keep) : "v"(voff), "s"(lds_dst), "s"(sbase) : "memory"); }
constexpr int NBS = 3;
constexpr int NL_SBUF = NBS * 16384;
constexpr int LUTS = 136, RLS = 264;
constexpr int NL_IMP = 2 * NL_SBUF, NL_LUT = NL_IMP + 64 * 132 * 4, NL_SELM = NL_LUT + 4 * LUTS * 4, NL_RLUT = NL_SELM + 64 * 16, NL_END = NL_RLUT + 4 * RLS * 4;
static_assert(NL_END <= LDS_BYTES - 64, "NSA LDS map");

struct NsaU { const bf16* qn; const bf16* kv; const bf16* kcmp; const float* gates; bf16* onsa; const float* relb; float kbound; };

#define NSA_READS(kbase, vbase) v4i16_t vr_[8]; const LAS unsigned char* kb_ = (kbase); const LAS unsigned char* vb_ = (vbase)
#define NSA_VREADS01() do { _Pragma("unroll") for (int ks = 0; ks < 2; ++ks) { vr_[4 * ks] = vtr(vb_ + ks * 2048); vr_[4 * ks + 1] = vtr(vb_ + ks * 2048 + 1024); vr_[4 * ks + 2] = vtr(vb_ + ks * 2048 + VD1); vr_[4 * ks + 3] = vtr(vb_ + ks * 2048 + 1024 + VD1); } \
        } while (0)
#define NSA_QK() do { bf16x8_t ka_[8]; _Pragma("unroll") for (int s = 0; s < 4; ++s) { \
        ka_[2 * s] = *(const LAS bf16x8_t*)(kb_ + (((2 * s + hi) ^ x7) << 4)); ka_[2 * s + 1] = *(const LAS bf16x8_t*)(kb_ + 4096 + (((2 * s + hi) ^ x7) << 4)); } \
        NSA_VREADS01(); _Pragma("unroll") for (int s = 0; s < 4; ++s) { \
        p0 = __builtin_amdgcn_mfma_f32_32x32x16_bf16(ka_[2 * s], qf[s], p0, 0, 0, 0); p1 = __builtin_amdgcn_mfma_f32_32x32x16_bf16(ka_[2 * s + 1], qf[s], p1, 0, 0, 0); } \
        __builtin_amdgcn_sched_group_barrier(0x100, 16, 0); __builtin_amdgcn_sched_group_barrier(0x008, 8, 0); \
        __builtin_amdgcn_sched_barrier(0); } while (0)
#define NSA_PV() do { u32x4 pk[4]; v4i16_t vs_[8]; \
        _Pragma("unroll") for (int ks = 2; ks < 4; ++ks) { vs_[4 * ks - 8] = vtr(vb_ + ks * 2048); vs_[4 * ks - 7] = vtr(vb_ + ks * 2048 + 1024); vs_[4 * ks - 6] = vtr(vb_ + ks * 2048 + VD1); vs_[4 * ks - 5] = vtr(vb_ + ks * 2048 + 1024 + VD1); } \
        pk[0] = (u32x4){cvtpk(p0[0], p0[1]), cvtpk(p0[2], p0[3]), cvtpk(p0[4], p0[5]), cvtpk(p0[6], p0[7])}; \
        pk[1] = (u32x4){cvtpk(p0[8], p0[9]), cvtpk(p0[10], p0[11]), cvtpk(p0[12], p0[13]), cvtpk(p0[14], p0[15])}; \
        pk[2] = (u32x4){cvtpk(p1[0], p1[1]), cvtpk(p1[2], p1[3]), cvtpk(p1[4], p1[5]), cvtpk(p1[6], p1[7])}; \
        pk[3] = (u32x4){cvtpk(p1[8], p1[9]), cvtpk(p1[10], p1[11]), cvtpk(p1[12], p1[13]), cvtpk(p1[14], p1[15])}; \
        _Pragma("unroll") for (int ks = 0; ks < 4; ++ks) { \
            const v4i16_t l0 = ks < 2 ? vr_[4 * ks] : vs_[4 * ks - 8], h0 = ks < 2 ? vr_[4 * ks + 1] : vs_[4 * ks - 7], l1 = ks < 2 ? vr_[4 * ks + 2] : vs_[4 * ks - 6], h1 = ks < 2 ? vr_[4 * ks + 3] : vs_[4 * ks - 5]; \
            const bf16x8_t vf0 = (bf16x8_t){l0[0], l0[1], l0[2], l0[3], h0[0], h0[1], h0[2], h0[3]}; \
            const bf16x8_t vf1 = (bf16x8_t){l1[0], l1[1], l1[2], l1[3], h1[0], h1[1], h1[2], h1[3]}; \
            const bf16x8_t pb = __builtin_bit_cast(bf16x8_t, pk[ks]); \
            o0 = __builtin_amdgcn_mfma_f32_32x32x16_bf16(vf0, pb, o0, 0, 0, 0); o1 = __builtin_amdgcn_mfma_f32_32x32x16_bf16(vf1, pb, o1, 0, 0, 0); } } while (0)
#define NSA_SOFTMAX_GENERAL(dbase_) do { const LAS float* lutr = lut + r * LUTS; const int a_ = (dbase_) - 64 * hi + 1; _Pragma("unroll") for (int i = 0; i < 16; ++i) { \
        const int c_ = 16 * ((i & 3) + 8 * (i >> 2)); int i0 = a_ - c_, i1 = a_ - c_ - 512; i0 = i0 < 0 ? 0 : (i0 > 129 ? 129 : i0); i1 = i1 < 0 ? 0 : (i1 > 129 ? 129 : i1); \
        p0[i] = fast_exp2(p0[i] + lutr[i0]); p1[i] = fast_exp2(p1[i] + lutr[i1]); } } while (0)

#define NSA_SOFTMAX_NEAR(dbase_) do { const LAS float* rb_ = (const LAS float*)(lds + NL_RLUT) + r * RLS + (191 - (dbase_) + 4 * hi); _Pragma("unroll") for (int i = 0; i < 16; ++i) { \
        p0[i] = fast_exp2(p0[i] + rb_[(i & 3) + 8 * (i >> 2)]); p1[i] = fast_exp2(p1[i] + rb_[32 + (i & 3) + 8 * (i >> 2)]); } } while (0)
#define NSA_SOFTMAX_FARMASK(dbase_, dmax_) do { const int lo_ = (dbase_) - (dmax_) - 4 * hi; _Pragma("unroll") for (int i = 0; i < 16; ++i) { \
        const int k0 = (i & 3) + 8 * (i >> 2); p0[i] = fast_exp2(k0 >= lo_ ? p0[i] : -1e30f); p1[i] = fast_exp2(k0 + 32 >= lo_ ? p1[i] : -1e30f); } } while (0)
__device__ __forceinline__ void nsa_unit(const NsaU& P, LAS unsigned char* lds_in, int bl, int g, int qb, const int wave_in) {
    int wave = wave_in; unsigned ldsu = (unsigned)(uintptr_t)lds_in; asm volatile("" : "+s"(wave), "+s"(ldsu));
    LAS unsigned char* lds = (LAS unsigned char*)(uintptr_t)ldsu;
    const int lane = lane_fresh(), tid = wave * 64 + lane, c = lane & 31, hi = lane >> 5;
    const int tok = 8 * wave + (c >> 2), r = c & 3, t0 = qb * 64, t = t0 + tok, cur = qb;
    const size_t tl = (size_t)bl * SEQ + t;
    LAS float* imp = (LAS float*)(lds + NL_IMP); LAS float* lut = (LAS float*)(lds + NL_LUT);
    const unsigned lds0 = (unsigned)(uintptr_t)lds;
    bf16x8_t qf[4];
    { const bf16* qrow = P.qn + tl * DM + (g * 4 + r) * 64;
#pragma unroll
      for (int s = 0; s < 4; ++s) qf[s] = *(const bf16x8_t*)(qrow + 16 * s + 8 * hi); }
    const size_t segkv = (size_t)(bl * NG + g) * SEQ * 64;
    const bf16* kcseg = P.kcmp + (size_t)(bl * NG + g) * NCMPP * 64; const bf16* vcseg = kcseg + (size_t)BPC * NG * NCMPP * 64;
    const bf16* ksseg = P.kv + 2 * KVSZ + segkv; const bf16* vsseg = P.kv + 3 * KVSZ + segkv;
    const bf16* kwseg = P.kv + 4 * KVSZ + segkv; const bf16* vwseg = P.kv + 5 * KVSZ + segkv;
    const int nc = (4 * cur + 2) / 64 + 1, w0 = cur > 8 ? cur - 8 : 0, nw = cur - w0 + 1;
    const int e1 = nc, e2 = 2 * nc, e2p = ((e2 + NBS - 1) / NBS) * NBS, e3 = e2p + nw, e3p = ((e3 + NBS - 1) / NBS) * NBS, nstepsA = e3p / NBS;
    const bool wpipe = cur >= 8;
    const int nstepsG = wpipe ? e2p / NBS : nstepsA;
    const int nf = cur > 2 ? cur - 2 : 0, nfp = ((nf + NBS - 1) / NBS) * NBS, nn = cur + 1 - nf, NT = e3p + nfp + nn, nsteps = nstepsA + nfp / NBS + 1;
    const int srow = tid >> 3, sch = tid & 7;
    const int ksrc = srow * 128 + ((sch ^ ((srow >> 1) & 7)) << 4), vsrc = srow * 128 + ((sch ^ (((srow >> 1) & 1) << 2)) << 4);
    const unsigned wdst = (unsigned)wave * 1024u;
#define NSA_GATE(k_) ([&]() { const int c_ = lane_fresh() & 31; \
        return P.gates[((size_t)bl * SEQ + qb * 64 + 8 * wave + (c_ >> 2)) * 48 + (g * 4 + (c_ & 3)) * 3 + (k_)]; }())
#define NSA_PARK ((LAS unsigned*)(lds + NL_IMP) + wave * 1056 + lane)
#define NSA_STAGE(ti, sbuf, b) do { int ti_ = (ti); ti_ = ti_ < NT ? ti_ : NT - 1;              \
        const bool isc_ = ti_ < e2, isw_ = ti_ < e3p; const int j_ = ti_ - e3p; \
        const int ic_ = ti_ < e1 ? ti_ : ti_ - e1, iw_ = w0 + (ti_ < e2p ? 0 : (ti_ < e3 ? ti_ : e3 - 1) - e2p), is_ = j_ < nfp ? (j_ < nf ? j_ : nf - 1) : nf + (j_ - nfp); \
        const int idx_ = isc_ ? ic_ : isw_ ? iw_ : is_; const bf16* kb_s = isc_ ? kcseg : isw_ ? kwseg : ksseg; const bf16* vb_s = isc_ ? vcseg : isw_ ? vwseg : vsseg; \
        glds16s(kb_s + (size_t)idx_ * 4096, (unsigned)ksrc, (unsigned)__builtin_amdgcn_readfirstlane((int)(lds0 + (unsigned)((sbuf) + (b) * 16384) + wdst))); \
        glds16s(vb_s + (size_t)idx_ * 4096, (unsigned)vsrc, (unsigned)__builtin_amdgcn_readfirstlane((int)(lds0 + (unsigned)((sbuf) + (b) * 16384 + 8192) + wdst))); } while (0)
#pragma unroll
    for (int b = 0; b < NBS; ++b) NSA_STAGE(b, 0, b);
    float qq = 0.f;
#pragma unroll
    for (int s = 0; s < 4; ++s)
#pragma unroll
        for (int e = 0; e < 8; ++e) { const float v = bf2f((unsigned short)qf[s][e]); qq += v * v; }
    qq = half_sum(qq);
    const float kb_ = lut[131];
    const float lutfar = lut[r * LUTS + 129], mref = sqrtf(qq) * kb_ + lut[r * LUTS + 130];
    const int x7 = (c >> 1) & 7;
    const int kfo = c * 128;
    const int vsw = (lane >> 3) & 1;
    const int vfo = (4 * hi + ((lane & 15) >> 2)) * 128 + (16 * ((lane >> 4) & 1) + 4 * (lane & 3)) * 2 + vsw * 64;
    const int VD1 = 64 - 128 * vsw;
    f32x16 o0, o1;
#pragma unroll
    for (int i = 0; i < 16; ++i) { o0[i] = 0.f; o1[i] = 0.f; }
    float lsum = 0.f, linv_c = 0.f, carry = 0.f;
    asm volatile("s_waitcnt vmcnt(0) lgkmcnt(0)" ::: "memory");
    __syncthreads();
#define NSA_WINDOW_END() do { \
                const float gt2 = NSA_GATE(2); const float l = half_sum(lsum); const float sc = gt2 * (l > 0.f ? fast_rcp(l) : 0.f); \
                LAS unsigned* park = NSA_PARK; \
_Pragma("unroll") \
                for (int i = 0; i < 8; ++i) { const unsigned a_ = park[64 * i], b_ = park[64 * (8 + i)]; \
                    park[64 * i] = cvtpk(__uint_as_float(a_ << 16) + sc * o0[2 * i], __uint_as_float(a_ & 0xffff0000u) + sc * o0[2 * i + 1]); \
                    park[64 * (8 + i)] = cvtpk(__uint_as_float(b_ << 16) + sc * o1[2 * i], __uint_as_float(b_ & 0xffff0000u) + sc * o1[2 * i + 1]); } \
_Pragma("unroll") \
                for (int i = 0; i < 16; ++i) { o0[i] = 0.f; o1[i] = 0.f; } \
                lsum = 0.f; \
        } while (0)
    for (int st = 0; st < nstepsG; ++st) {
        const int sbuf = (st & 1) * NL_SBUF;
        if (st + 1 < nsteps) {
#pragma unroll
            for (int b = 0; b < NBS; ++b) NSA_STAGE((st + 1) * NBS + b, sbuf ^ NL_SBUF, b);
        }
#pragma unroll 1
        for (int b = 0; b < NBS; ++b) {
            const int ti = st * NBS + b;
            if (ti >= e3) break;
            if (ti >= e2 && ti < e2p) continue;
            const int mode = ti < e1 ? 0 : ti < e2 ? 1 : 3;
            int dbase, kstep, dmax; bool fast, colsel = true; int kind;
            if (mode < 2) { const int cc = mode == 0 ? ti : ti - e1; dbase = t - 16 * 64 * cc - 31; kstep = 16; dmax = 0x7fffffff; fast = (t0 - (16 * (64 * cc + 63) + 31)) >= 128; kind = fast ? 0 : 3; }
            else { const int ww = w0 + ti - e2p; dbase = t - 64 * ww; kstep = 1; dmax = WIN - 1; fast = (cur - ww) >= 3; kind = (cur - ww) <= 2 ? 1 : (cur - ww) <= 7 ? 0 : 2; }
            {
                const float cin = colsel ? (fast ? lutfar - mref : -mref) : -1e30f;
                f32x16 p0, p1;
#pragma unroll
                for (int i = 0; i < 16; ++i) { p0[i] = cin; p1[i] = cin; }
                NSA_READS(lds + sbuf + b * 16384 + kfo, lds + sbuf + b * 16384 + 8192 + vfo);
                NSA_QK();
                if (kind == 0) {
#pragma unroll
                    for (int i = 0; i < 16; ++i) { p0[i] = fast_exp2(p0[i]); p1[i] = fast_exp2(p1[i]); }
                } else if (kind == 1) NSA_SOFTMAX_NEAR(dbase);
                else if (kind == 2) NSA_SOFTMAX_FARMASK(dbase, dmax);
                else NSA_SOFTMAX_GENERAL(dbase);
                if (mode == 1) {
#pragma unroll
                    for (int i = 0; i < 16; ++i) { p0[i] *= linv_c; p1[i] *= linv_c; }
                    const int cc = ti - e1;
                    float A0[4], B0[4], A1[4], B1[4];
#pragma unroll
                    for (int q4 = 0; q4 < 4; ++q4) {
                        A0[q4] = p0[4 * q4] + p0[4 * q4 + 1] + p0[4 * q4 + 2] + 0.5f * p0[4 * q4 + 3]; B0[q4] = 0.5f * p0[4 * q4 + 3];
                        A1[q4] = p1[4 * q4] + p1[4 * q4 + 1] + p1[4 * q4 + 2] + 0.5f * p1[4 * q4 + 3]; B1[q4] = 0.5f * p1[4 * q4 + 3];
                        A0[q4] += dpp_x1(A0[q4]); A0[q4] += dpp_x2(A0[q4]); B0[q4] += dpp_x1(B0[q4]); B0[q4] += dpp_x2(B0[q4]);
                        A1[q4] += dpp_x1(A1[q4]); A1[q4] += dpp_x2(A1[q4]); B1[q4] += dpp_x1(B1[q4]); B1[q4] += dpp_x2(B1[q4]);
                    }
                    float Bl0[4], Bu0[4], Bl1[4], Bu1[4];
#pragma unroll
                    for (int q4 = 0; q4 < 4; ++q4) {
                        { auto rr = __builtin_amdgcn_permlane32_swap(__float_as_uint(B0[q4]), __float_as_uint(B0[q4]), false, false); Bl0[q4] = __uint_as_float(rr[0]); Bu0[q4] = __uint_as_float(rr[1]); }
                        { auto rr = __builtin_amdgcn_permlane32_swap(__float_as_uint(B1[q4]), __float_as_uint(B1[q4]), false, false); Bl1[q4] = __uint_as_float(rr[0]); Bu1[q4] = __uint_as_float(rr[1]); }
                    }
                    LAS float* irow = imp + tok * 132 + 16 * cc + hi;
#pragma unroll
                    for (int q4 = 0; q4 < 4; ++q4) {
                        const float s0 = hi ? Bl0[q4] : (q4 == 0 ? carry : Bu0[q4 - 1]);
                        const float s1 = hi ? Bl1[q4] : (q4 == 0 ? Bu0[3] : Bu1[q4 - 1]);
                        if (r == 0) { irow[2 * q4] = A0[q4] + s0; irow[8 + 2 * q4] = A1[q4] + s1; }
                    }
                    carry = Bu1[3];
                } else {
                    float s8[8];
#pragma unroll
                    for (int i = 0; i < 8; ++i) s8[i] = (p0[2 * i] + p0[2 * i + 1]) + (p1[2 * i] + p1[2 * i + 1]);
                    lsum += ((s8[0] + s8[1]) + (s8[2] + s8[3])) + ((s8[4] + s8[5]) + (s8[6] + s8[7]));
                }
                if (mode != 0) NSA_PV();
            }
            if (ti == e1 - 1) { const float l = half_sum(lsum); linv_c = l > 0.f ? fast_rcp(l) : 0.f; lsum = 0.f; carry = 0.f; }
            if (ti == e2 - 1) {
                asm volatile("s_waitcnt lgkmcnt(0)" ::: "memory");
                {
                    const int tk = lane >> 3, sub = lane & 7, j0 = sub * 16;
                    const LAS float* irow = imp + (8 * wave + tk) * 132 + j0;
                    unsigned s_[16];
#pragma unroll
                    for (int q = 0; q < 4; ++q) { const f32x4 v = *(const LAS f32x4*)(irow + 4 * q);
#pragma unroll
                        for (int e = 0; e < 4; ++e) { const int j = j0 + 4 * q + e; s_[4 * q + e] = (j >= 1 && j <= cur - 2) ? ((__float_as_uint(v[e]) & ~127u) | (unsigned)(127 - j)) : 0u; } }
#define CE(a_, b_) do { const unsigned hi_ = max(s_[a_], s_[b_]), lo_ = min(s_[a_], s_[b_]); s_[a_] = hi_; s_[b_] = lo_; } while (0)
                    CE(0, 1); CE(2, 3); CE(0, 2); CE(1, 3); CE(1, 2); CE(4, 5); CE(6, 7); CE(4, 6); CE(5, 7); CE(5, 6); CE(0, 4); CE(2, 6); CE(2, 4); CE(1, 5); CE(3, 7); CE(3, 5); CE(1, 2); CE(3, 4); CE(5, 6); CE(8, 9); CE(10, 11); CE(8, 10); CE(9, 11); CE(9, 10); CE(12, 13); CE(14, 15); CE(12, 14); CE(13, 15); CE(13, 14); CE(8, 12); CE(10, 14); CE(10, 12); CE(9, 13); CE(11, 15); CE(11, 13); CE(9, 10); CE(11, 12); CE(13, 14); CE(0, 8); CE(4, 12); CE(4, 8); CE(2, 10); CE(6, 14); CE(6, 10); CE(2, 4); CE(6, 8); CE(10, 12); CE(1, 9); CE(5, 13); CE(5, 9); CE(3, 11); CE(7, 15); CE(7, 11); CE(3, 5); CE(7, 9); CE(11, 13); CE(1, 2); CE(3, 4); CE(5, 6); CE(7, 8); CE(9, 10); CE(11, 12); CE(13, 14);
#undef CE
                    unsigned bits = 0u;
                    if (j0 == 0) bits |= 1u;
                    if ((cur >> 4) == sub) bits |= 1u << (cur & 15);
                    if (cur >= 1 && ((cur - 1) >> 4) == sub) bits |= 1u << ((cur - 1) & 15);
                    const int nforced = 1 + (cur >= 1 ? 1 : 0) + (cur >= 2 ? 1 : 0);
                    for (int it = nforced; it < NTOP; ++it) {
                        unsigned gm = s_[0];
                        gm = max(gm, (unsigned)__builtin_amdgcn_mov_dpp((int)gm, 0xB1, 0xf, 0xf, true));
                        gm = max(gm, (unsigned)__builtin_amdgcn_mov_dpp((int)gm, 0x4E, 0xf, 0xf, true));
                        gm = max(gm, (unsigned)__builtin_amdgcn_mov_dpp((int)gm, 0x141, 0xf, 0xf, true));
                        if (__ballot(gm != 0u) == 0ull) break;
                        const bool own = (s_[0] == gm) && gm != 0u;
                        bits |= own ? (1u << ((127u - (gm & 127u)) & 15u)) : 0u;
#pragma unroll
                        for (int i = 0; i < 15; ++i) s_[i] = own ? s_[i + 1] : s_[i];
                        s_[15] = own ? 0u : s_[15];
                    }
                    LAS unsigned short* sm16 = (LAS unsigned short*)(lds + NL_SELM);
                    sm16[(8 * wave + tk) * 8 + sub] = (unsigned short)bits;
                    asm volatile("s_waitcnt lgkmcnt(0)" ::: "memory");
                }
                { const float gt0 = NSA_GATE(0); LAS unsigned* park = NSA_PARK;
#pragma unroll
                  for (int i = 0; i < 8; ++i) { park[64 * i] = cvtpk(gt0 * o0[2 * i], gt0 * o0[2 * i + 1]); park[64 * (8 + i)] = cvtpk(gt0 * o1[2 * i], gt0 * o1[2 * i + 1]); }
#pragma unroll
                  for (int i = 0; i < 16; ++i) { o0[i] = 0.f; o1[i] = 0.f; } }
            }
            if (ti == e3 - 1) NSA_WINDOW_END();
        }
        asm volatile("s_waitcnt vmcnt(0) lgkmcnt(0)" ::: "memory");
        __syncthreads();
    }
    {
    const float mref_o = mref;
#define SBAR() __builtin_amdgcn_sched_barrier(0)
#define PIN(x) asm volatile("" : "+v"(x))
#define MFMA32(a, b, c) __builtin_amdgcn_mfma_f32_32x32x16_bf16(a, b, c, 0, 0, 0)
#define PKW(P, i) cvtpk_c(P[i], P[(i) + 1])
#define NB_KX(s) ((s) == 0 ? kx0 : (s) == 1 ? kx1 : (s) == 2 ? kx2 : kx3)
#define NB_KLD2(kk, s) do { const LAS unsigned char* kq_ = tb + (kk) * 16384 + kfo + NB_KX(s); kf[2 * (s)] = *(const LAS bf16x8_t*)(kq_); kf[2 * (s) + 1] = *(const LAS bf16x8_t*)(kq_ + 4096); } while (0)
#define NB_KRD(G, kk, s) do { if (G) { NB_KLD2(kk, s); SBAR(); } } while (0)
#define NB_VRD(j) do { vlo[j] = vtr(vq_ + ((j) >> 1) * 2048 + (((j) & 1) ? VD1 : 0)); vhi[j] = vtr(vq_ + ((j) >> 1) * 2048 + 1024 + (((j) & 1) ? VD1 : 0)); } while (0)
#define NB_VFR(j) (bf16x8_t){vlo[j][0], vlo[j][1], vlo[j][2], vlo[j][3], vhi[j][0], vhi[j][1], vhi[j][2], vhi[j][3]}
#define NB_PAF(k) __builtin_bit_cast(bf16x8_t, pw##k)
#define NB_GAPA(MF, a0, a1, a2, a3, D0, E0, D1, E1) do { MF; sacc += a0; sacc += a1; sacc += a2; sacc += a3; unsigned w0_ = E0, w1_ = E1; PIN(w0_); PIN(w1_); D0 = w0_; D1 = w1_; PIN(sacc); SBAR(); } while (0)
#define FIX0(x, i, H) (x)
#define FIXM(x, i, H) (((((i) & 3) + 8 * ((i) >> 2) + 32 * (H)) >= lo_) ? (x) : -1e30f)
#define FIX1(x, i, H) ((x) + rb_[32 * (H) + ((i) & 3) + 8 * ((i) >> 2)])
#define NB_GAPB(MF, X, i, H, FIX) do { MF; X[i] = fast_exp2(FIX(X[i], (i), H)); X[(i) + 1] = fast_exp2(FIX(X[(i) + 1], (i) + 1, H)); X[(i) + 2] = fast_exp2(FIX(X[(i) + 2], (i) + 2, H)); X[(i) + 3] = fast_exp2(FIX(X[(i) + 3], (i) + 3, H)); PIN(X); SBAR(); } while (0)
#define NB_GAPBP(OD, MF, X, i, H, FIX) do { MF; PIN(OD); X[i] = fast_exp2(FIX(X[i], (i), H)); X[(i) + 1] = fast_exp2(FIX(X[(i) + 1], (i) + 1, H)); X[(i) + 2] = fast_exp2(FIX(X[(i) + 2], (i) + 2, H)); X[(i) + 3] = fast_exp2(FIX(X[(i) + 3], (i) + 3, H)); PIN(X); SBAR(); } while (0)
#define NB_CIN(cval) f32x16 cinv; { float cin_ = (cval); asm volatile("" : "+v"(cin_));            \
        _Pragma("unroll") for (int i = 0; i < 16; ++i) cinv[i] = cin_; }
#define NB_HEAD(C0, C1, cval, kk, GL, knext, FIX) do { SBAR(); NB_KLD2(kk, 0); NB_KLD2(kk, 1); NB_KLD2(kk, 2); NB_KLD2(kk, 3); NB_CIN(cval); SBAR(); \
        C0 = MFMA32(kf[0], qf[0], cinv); C0 = MFMA32(kf[2], qf[1], C0); C0 = MFMA32(kf[4], qf[2], C0); C0 = MFMA32(kf[6], qf[3], C0); SBAR();            \
        C1 = MFMA32(kf[1], qf[0], cinv); SBAR(); \
        NB_GAPBP(C1, C1 = MFMA32(kf[3], qf[1], C1), C0, 0, 0, FIX); NB_GAPBP(C1, C1 = MFMA32(kf[5], qf[2], C1), C0, 4, 0, FIX); NB_GAPBP(C1, C1 = MFMA32(kf[7], qf[3], C1), C0, 8, 0, FIX); \
        if (GL) { NB_KLD2(knext, 0); NB_KLD2(knext, 1); NB_KLD2(knext, 2); NB_KLD2(knext, 3); SBAR(); } \
        NB_GAPB((void)0, C0, 12, 0, FIX); NB_GAPB((void)0, C1, 0, 1, FIX); NB_GAPB((void)0, C1, 4, 1, FIX); NB_GAPB((void)0, C1, 8, 1, FIX); NB_GAPB((void)0, C1, 12, 1, FIX); } while (0)
#define NB_STEP(C0, C1, cval, P0, P1, kprev, GL, knext, FIX) NB_STEPK(C0, C1, cval, P0, P1, kprev, GL, knext, FIX, false, 0)
#define NB_STEPK(C0, C1, cval, P0, P1, kprev, GL, knext, FIX, KL, kcur) do { SBAR(); if (KL) { NB_KLD2(kcur, 0); NB_KLD2(kcur, 1); NB_KLD2(kcur, 2); NB_KLD2(kcur, 3); SBAR(); }     \
        const LAS unsigned char* vq_ = tb + (kprev) * 16384 + 8192 + vfo; NB_CIN(cval); \
        float sacc = P0[0] + P0[1]; \
                           NB_GAPA(C0 = MFMA32(kf[0], qf[0], cinv), P0[2], P0[3], P0[4], P0[5],     pw0[0], PKW(P0, 0), pw0[1], PKW(P0, 2)); \
                           NB_GAPA(C1 = MFMA32(kf[1], qf[0], cinv), P0[6], P0[7], P0[8], P0[9],     pw0[2], PKW(P0, 4), pw0[3], PKW(P0, 6)); PIN(cinv); SBAR(); \
                           NB_GAPA(C0 = MFMA32(kf[2], qf[1], C0),   P0[10], P0[11], P0[12], P0[13], pw1[0], PKW(P0, 8), pw1[1], PKW(P0, 10)); \
                           NB_GAPA(C1 = MFMA32(kf[3], qf[1], C1),   P0[14], P0[15], P1[0], P1[1],   pw1[2], PKW(P0, 12), pw1[3], PKW(P0, 14)); \
        NB_VRD(0); SBAR(); NB_GAPA(C0 = MFMA32(kf[4], qf[2], C0),   P1[2], P1[3], P1[4], P1[5],     pw2[0], PKW(P1, 0), pw2[1], PKW(P1, 2)); \
        NB_VRD(1); SBAR(); NB_GAPA(C1 = MFMA32(kf[5], qf[2], C1),   P1[6], P1[7], P1[8], P1[9],     pw2[2], PKW(P1, 4), pw2[3], PKW(P1, 6)); \
        NB_VRD(2); SBAR(); NB_GAPA(C0 = MFMA32(kf[6], qf[3], C0),   P1[10], P1[11], P1[12], P1[13], pw3[0], PKW(P1, 8), pw3[1], PKW(P1, 10)); \
        NB_VRD(3); SBAR(); NB_GAPA(C1 = MFMA32(kf[7], qf[3], C1),   P1[14], P1[15], 0.f, 0.f,       pw3[2], PKW(P1, 12), pw3[3], PKW(P1, 14)); \
        lsum += sacc; SBAR(); \
        NB_VRD(4); SBAR(); NB_GAPBP(o0, o0 = MFMA32(NB_VFR(0), NB_PAF(0), o0), C0, 0, 0, FIX); \
        NB_VRD(5); SBAR(); NB_GAPBP(o1, o1 = MFMA32(NB_VFR(1), NB_PAF(0), o1), C0, 4, 0, FIX); \
        NB_VRD(6); SBAR(); NB_GAPBP(o0, o0 = MFMA32(NB_VFR(2), NB_PAF(1), o0), C0, 8, 0, FIX); \
        NB_VRD(7); SBAR(); NB_GAPBP(o1, o1 = MFMA32(NB_VFR(3), NB_PAF(1), o1), C0, 12, 0, FIX); \
        NB_KRD(GL, knext, 0); NB_GAPBP(o0, o0 = MFMA32(NB_VFR(4), NB_PAF(2), o0), C1, 0, 1, FIX); NB_KRD(GL, knext, 1); NB_GAPBP(o1, o1 = MFMA32(NB_VFR(5), NB_PAF(2), o1), C1, 4, 1, FIX); \
        NB_KRD(GL, knext, 2); NB_GAPBP(o0, o0 = MFMA32(NB_VFR(6), NB_PAF(3), o0), C1, 8, 1, FIX); NB_KRD(GL, knext, 3); NB_GAPBP(o1, o1 = MFMA32(NB_VFR(7), NB_PAF(3), o1), C1, 12, 1, FIX); \
        } while (0)
#define NB_TGAP(MF, a0, a1, a2, a3, a4, a5, a6, a7, D0, E0, D1, E1, D2, E2, D3, E3) do { MF; sacc += a0; sacc += a1; sacc += a2; sacc += a3; sacc += a4; sacc += a5; sacc += a6; sacc += a7; \
        unsigned w0_ = E0, w1_ = E1, w2_ = E2, w3_ = E3; PIN(w0_); PIN(w1_); PIN(w2_); PIN(w3_); D0 = w0_; D1 = w1_; D2 = w2_; D3 = w3_; PIN(sacc); SBAR(); } while (0)
#define NB_TAIL(P0, P1, kprev) do { SBAR(); const LAS unsigned char* vq_ = tb + (kprev) * 16384 + 8192 + vfo; \
        _Pragma("unroll") for (int j = 0; j < 8; ++j) NB_VRD(j); \
        float sacc = 0.f; \
        NB_TGAP((void)0, P0[0], P0[1], P0[2], P0[3], P0[4], P0[5], P0[6], P0[7], pw0[0], PKW(P0, 0), pw0[1], PKW(P0, 2), pw0[2], PKW(P0, 4), pw0[3], PKW(P0, 6)); \
        o0 = MFMA32(NB_VFR(0), NB_PAF(0), o0); \
        NB_TGAP(o1 = MFMA32(NB_VFR(1), NB_PAF(0), o1), P0[8], P0[9], P0[10], P0[11], P0[12], P0[13], P0[14], P0[15], pw1[0], PKW(P0, 8), pw1[1], PKW(P0, 10), pw1[2], PKW(P0, 12), pw1[3], PKW(P0, 14)); \
        o0 = MFMA32(NB_VFR(2), NB_PAF(1), o0); \
        NB_TGAP(o1 = MFMA32(NB_VFR(3), NB_PAF(1), o1), P1[0], P1[1], P1[2], P1[3], P1[4], P1[5], P1[6], P1[7], pw2[0], PKW(P1, 0), pw2[1], PKW(P1, 2), pw2[2], PKW(P1, 4), pw2[3], PKW(P1, 6)); \
        o0 = MFMA32(NB_VFR(4), NB_PAF(2), o0); \
        NB_TGAP(o1 = MFMA32(NB_VFR(5), NB_PAF(2), o1), P1[8], P1[9], P1[10], P1[11], P1[12], P1[13], P1[14], P1[15], pw3[0], PKW(P1, 8), pw3[1], PKW(P1, 10), pw3[2], PKW(P1, 12), pw3[3], PKW(P1, 14)); \
        o0 = MFMA32(NB_VFR(6), NB_PAF(3), o0); o1 = MFMA32(NB_VFR(7), NB_PAF(3), o1); lsum += sacc; SBAR(); } while (0)
#pragma unroll 1
    for (int st = nstepsG; st < nsteps; ++st) {
        f32x16 pA0, pA1, pB0, pB1; bf16x8_t kf[8]; v4i16_t vlo[8], vhi[8]; u32x4 pw0, pw1, pw2, pw3;
        const int lane = lane_fresh(), c = lane & 31, hi = lane >> 5, r = c & 3, tok = 8 * wave + (c >> 2), t = t0 + tok;
        const int x7 = (c >> 1) & 7, kfo = c * 128, vsw = (lane >> 3) & 1, vfo = (4 * hi + ((lane & 15) >> 2)) * 128 + (16 * ((lane >> 4) & 1) + 4 * (lane & 3)) * 2 + vsw * 64, VD1 = 64 - 128 * vsw;
        const int kx0 = ((0 + hi) ^ x7) << 4, kx1 = ((2 + hi) ^ x7) << 4, kx2 = ((4 + hi) ^ x7) << 4, kx3 = ((6 + hi) ^ x7) << 4;
        float mref = mref_o; asm volatile("" : "+v"(mref)); const float cfar = lut[r * LUTS + 129] - mref;
        if (st == nsteps - 1) {
    {
        const LAS unsigned char* tb = lds + ((nsteps - 1) & 1) * NL_SBUF;
        const LAS float* rlb = (const LAS float*)(lds + NL_RLUT) + r * RLS + 191 + 4 * hi;
        const LAS unsigned* swp = (const LAS unsigned*)(lds + NL_SELM + tok * 16);
#define NEAR_SETUP(b_) const int jj_ = (nf + (b_)) < cur ? (nf + (b_)) : cur; const bool cs_ = ((b_) < nn) && ((swp[jj_ >> 5] >> (jj_ & 31)) & 1u); \
        const LAS float* rb_ = rlb - (t - 64 * jj_); const float cv_ = cs_ ? -mref : -1e30f
        { NEAR_SETUP(0); NB_HEAD(pA0, pA1, cv_, 0, false, 0, FIX1); }
        { NEAR_SETUP(1); NB_STEPK(pB0, pB1, cv_, pA0, pA1, 0, false, 0, FIX1, true, 1); }
        { NEAR_SETUP(2); NB_STEPK(pA0, pA1, cv_, pB0, pB1, 1, false, 0, FIX1, true, 2); }
        NB_TAIL(pA0, pA1, 2);
#undef NEAR_SETUP
    }
            break;
        }
        if (st < nstepsA) {
            const int sbufw = (st & 1) * NL_SBUF;
#pragma unroll
            for (int b = 0; b < NBS; ++b) NSA_STAGE((st + 1) * NBS + b, sbufw ^ NL_SBUF, b);
            const LAS unsigned char* tb = lds + sbufw; const int sw = st - nstepsG; const int db0 = t - 64 * (w0 + 3 * sw);
            if (sw < 2) {
                { const int lo_ = db0 - (WIN - 1) - 4 * hi;       NB_HEAD(pA0, pA1, cfar, 0, false, 0, FIXM); }
                { const int lo_ = db0 - 64 - (WIN - 1) - 4 * hi;  NB_STEPK(pB0, pB1, cfar, pA0, pA1, 0, false, 0, FIXM, true, 1); }
                { const int lo_ = db0 - 128 - (WIN - 1) - 4 * hi; NB_STEPK(pA0, pA1, cfar, pB0, pB1, 1, false, 0, FIXM, true, 2); }
                NB_TAIL(pA0, pA1, 2);
            } else {
                const LAS float* rlb = (const LAS float*)(lds + NL_RLUT) + r * RLS + 191 + 4 * hi; const float cv_ = -mref;
                { const LAS float* rb_ = rlb - db0;         NB_HEAD(pA0, pA1, cv_, 0, false, 0, FIX1); }
                { const LAS float* rb_ = rlb - (db0 - 64);  NB_STEPK(pB0, pB1, cv_, pA0, pA1, 0, false, 0, FIX1, true, 1); }
                { const LAS float* rb_ = rlb - (db0 - 128); NB_STEPK(pA0, pA1, cv_, pB0, pB1, 1, false, 0, FIX1, true, 2); }
                NB_TAIL(pA0, pA1, 2);
                NSA_WINDOW_END();
            }
            asm volatile("s_waitcnt vmcnt(0) lgkmcnt(0)" ::: "memory");
            __syncthreads();
            continue;
        }
        const int sbuf = (st & 1) * NL_SBUF;
        const int j0 = (st - nstepsA) * NBS;
        const LAS unsigned* swp = (const LAS unsigned*)(lds + NL_SELM + tok * 16);
        const int wi = j0 >> 5; const unsigned wa_ = swp[wi], wb_ = swp[wi < 3 ? wi + 1 : 3];
        {
          const int jn = j0 + NBS; const bool nextnear = jn >= nfp;
#pragma unroll
          for (int b = 0; b < NBS; ++b) { int jj = nextnear ? nf + b : jn + b; const int jmax = nextnear ? cur : nf - 1; jj = jj < jmax ? jj : jmax;
              glds16s(ksseg + (size_t)jj * 4096, (unsigned)ksrc, (unsigned)__builtin_amdgcn_readfirstlane((int)(lds0 + (unsigned)((sbuf ^ NL_SBUF) + b * 16384) + wdst)));
              glds16s(vsseg + (size_t)jj * 4096, (unsigned)vsrc, (unsigned)__builtin_amdgcn_readfirstlane((int)(lds0 + (unsigned)((sbuf ^ NL_SBUF) + b * 16384 + 8192) + wdst))); } }
        const int bend = (nf - j0) < NBS ? (nf - j0) : NBS;
        {
            const unsigned sel3 = (unsigned)((((unsigned long long)wb_ << 32) | wa_) >> (j0 & 31));
            const bool cs0 = sel3 & 1u, cs1 = (1 < bend) && (sel3 & 2u), cs2 = (2 < bend) && (sel3 & 4u);
            const bool n0 = __ballot(cs0) != 0ull, n1 = __ballot(cs1) != 0ull, n2 = __ballot(cs2) != 0ull;
            const int cnt = (n0 ? 1 : 0) + (n1 ? 1 : 0) + (n2 ? 1 : 0);
            const int ka = n0 ? 0 : n1 ? 1 : 2, kb2 = (n0 && n1) ? 1 : 2;
            const bool csa = ka == 0 ? cs0 : ka == 1 ? cs1 : cs2, csb = kb2 == 1 ? cs1 : cs2, csc = cs2;
            const LAS unsigned char* tb = lds + sbuf;
            if (cnt == 1) { NB_HEAD(pA0, pA1, (csa ? cfar : -1e30f), ka, false, 0, FIX0); NB_TAIL(pA0, pA1, ka); }
            else if (cnt == 2) { NB_HEAD(pA0, pA1, (csa ? cfar : -1e30f), ka, true, kb2, FIX0); NB_STEP(pB0, pB1, (csb ? cfar : -1e30f), pA0, pA1, ka, false, 0, FIX0); NB_TAIL(pB0, pB1, kb2); }
            else if (cnt == 3) { NB_HEAD(pA0, pA1, (csa ? cfar : -1e30f), 0, true, 1, FIX0); NB_STEP(pB0, pB1, (csb ? cfar : -1e30f), pA0, pA1, 0, true, 2, FIX0); NB_STEP(pA0, pA1, (csc ? cfar : -1e30f), pB0, pB1, 1, false, 0, FIX0); NB_TAIL(pA0, pA1, 2); }
        }
        asm volatile("s_waitcnt vmcnt(0) lgkmcnt(0)" ::: "memory");
        __syncthreads();
    }
#undef NB_KX
#undef NB_KLD2
#undef NB_KRD
#undef NB_VRD
#undef NB_VFR
#undef NB_PAF
#undef NB_GAPA
#undef NB_GAPB
#undef NB_GAPBP
#undef NB_CIN
#undef NB_HEAD
#undef NB_STEP
#undef NB_STEPK
#undef NB_TAIL
#undef NB_TGAP
    }
#undef NSA_STAGE
#undef NSA_GATE
#undef NSA_WINDOW_END
#undef NSA_PARK
    { const int lane2 = lane_fresh(), wave2 = wave, c2 = lane2 & 31, hi2 = lane2 >> 5, r2 = c2 & 3;
      const size_t tl2 = (size_t)bl * SEQ + qb * 64 + 8 * wave2 + (c2 >> 2);
      const float gt1b = P.gates[tl2 * 48 + (g * 4 + r2) * 3 + 1];
      const float l = half_sum(lsum); const float sc = gt1b * (l > 0.f ? fast_rcp(l) : 0.f);
      const LAS unsigned* park = (const LAS unsigned*)(lds + NL_IMP) + wave2 * 1056 + lane2;
      bf16* orow = P.onsa + tl2 * DM + (g * 4 + r2) * 64; const int hi = hi2;
#pragma unroll
      for (int q4 = 0; q4 < 4; ++q4) {
          const unsigned a0 = park[64 * (2 * q4)], a1 = park[64 * (2 * q4 + 1)], b0 = park[64 * (8 + 2 * q4)], b1 = park[64 * (8 + 2 * q4 + 1)];
          u32x2 w0_; w0_.x = cvtpk(__uint_as_float(a0 << 16) + sc * o0[4 * q4], __uint_as_float(a0 & 0xffff0000u) + sc * o0[4 * q4 + 1]);
                     w0_.y = cvtpk(__uint_as_float(a1 << 16) + sc * o0[4 * q4 + 2], __uint_as_float(a1 & 0xffff0000u) + sc * o0[4 * q4 + 3]);
          u32x2 w1_; w1_.x = cvtpk(__uint_as_float(b0 << 16) + sc * o1[4 * q4], __uint_as_float(b0 & 0xffff0000u) + sc * o1[4 * q4 + 1]);
                     w1_.y = cvtpk(__uint_as_float(b1 << 16) + sc * o1[4 * q4 + 2], __uint_as_float(b1 & 0xffff0000u) + sc * o1[4 * q4 + 3]);
          *(u32x2*)(orow + 8 * q4 + 4 * hi) = w0_; *(u32x2*)(orow + 32 + 8 * q4 + 4 * hi) = w1_;
      } }
    asm volatile("s_waitcnt lgkmcnt(0)" ::: "memory");
    __syncthreads();
}
#undef NSA_READS
#undef NSA_VREADS01
#undef NSA_SOFTMAX_NEAR
#undef NSA_SOFTMAX_FARMASK
#undef NSA_QK
#undef NSA_PV
#undef NSA_SOFTMAX_GENERAL

constexpr int ML_A = 0, ML_ABUF = 32768, ML_B = 65536, ML_BBUF = 32768;
__device__ __forceinline__ void mem_unit_lds(const bf16* qm, const bf16* kmn, const bf16* vmt, bf16* omem, LAS unsigned char* lds, int tl0, int bglob, int hm, float mref, const int wave, const bool first, const bf16* kb_next, bf16x8_t (&qf)[16], const bf16* qm_next) {
    const int lane = lane_fresh(), tid = wave * 64 + lane, c = lane & 31, hi = lane >> 5;
    const unsigned lds0 = (unsigned)(uintptr_t)lds;
    { const bf16* qrow = qm + (size_t)(tl0 + 32 * wave + c) * DM + hm * MHD + 8 * hi;
#pragma unroll
      for (int s = 0; s < 16; ++s) qf[s] = *(const bf16x8_t*)(qrow + 16 * s); }
    const bf16* kb = kmn + (size_t)(bglob * MH + hm) * NMEM * MHD;
    const bf16* vb = vmt + (size_t)(bglob * MH + hm) * NMEM * MHD;
    int ksrc[4], vsrc[2];
#pragma unroll
    for (int i = 0; i < 4; ++i) { const int p = i * 512 + tid, row = p >> 5, ch = (p & 31) ^ (row & 15); ksrc[i] = (row * MHD + ch * 8) * 2; }
#pragma unroll
    for (int i = 0; i < 2; ++i) { const int p = i * 512 + tid, row = p >> 3, sl = (p & 7) ^ ((row >> 1) & 7); vsrc[i] = (row * NMEM + sl * 8) * 2; }
    const unsigned wdst = (unsigned)wave * 1024u;
#define MEM_DMA_K(kbase, mt, buf) do { _Pragma("unroll") for (int i_ = 0; i_ < 4; ++i_) \
        glds16((const char*)((kbase) + (size_t)(64 * (mt)) * MHD) + ksrc[i_], (unsigned)__builtin_amdgcn_readfirstlane((int)(lds0 + ML_A + (buf) * ML_ABUF + i_ * 8192 + wdst))); } while (0)
#define MEM_DMA_V(j, buf) do { _Pragma("unroll") for (int h_ = 0; h_ < 2; ++h_) { const int it_ = 2 * (j) + h_; _Pragma("unroll") for (int i_ = 0; i_ < 2; ++i_) \
        glds16((const char*)(vb + (size_t)(128 * (it_ >> 2)) * NMEM + 64 * (it_ & 3)) + vsrc[i_], (unsigned)__builtin_amdgcn_readfirstlane((int)(lds0 + ML_B + (buf) * ML_BBUF + h_ * 16384 + i_ * 8192 + wdst))); } } while (0)
    if (first) { MEM_DMA_K(kb, 0, 0); MEM_DMA_K(kb, 1, 1); }
    MEM_DMA_V(0, 0); MEM_DMA_V(1, 1);
    asm volatile("s_waitcnt vmcnt(8)" ::: "memory");
    float ss = 0.f;
#pragma unroll
    for (int s = 0; s < 16; ++s)
#pragma unroll
        for (int e = 0; e < 8; ++e) { const float v = bf2f((unsigned short)qf[s][e]); ss += v * v; }
    ss = half_sum(ss);
    const float f = rsqrtf(ss * (1.f / MHD) + EPS) * (LOG2E / 16.f);
    asm volatile("s_waitcnt lgkmcnt(0)" ::: "memory");
    __syncthreads();
    u32x4 pk[4][4]; float lsum = 0.f;
    const int kfo = c * 512, x15 = c & 15;
#pragma unroll
    for (int mt = 0; mt < 4; ++mt) {
        f32x16 p0, p1;
#pragma unroll
        for (int i = 0; i < 16; ++i) { p0[i] = 0.f; p1[i] = 0.f; }
        const LAS unsigned char* ka = lds + ML_A + (mt & 1) * ML_ABUF + kfo;
#pragma unroll
        for (int s = 0; s < 16; ++s) {
            const bf16x8_t a0 = *(const LAS bf16x8_t*)(ka + (((2 * s + hi) ^ x15) << 4)), a1 = *(const LAS bf16x8_t*)(ka + 32 * 512 + (((2 * s + hi) ^ x15) << 4));
            p0 = __builtin_amdgcn_mfma_f32_32x32x16_bf16(a0, qf[s], p0, 0, 0, 0);
            p1 = __builtin_amdgcn_mfma_f32_32x32x16_bf16(a1, qf[s], p1, 0, 0, 0);
            if ((s & 3) == 3) { __builtin_amdgcn_sched_group_barrier(0x100, 8, 0); __builtin_amdgcn_sched_group_barrier(0x008, 8, 0); __builtin_amdgcn_sched_barrier(0); }
        }
        float sm = 0.f;
#pragma unroll
        for (int i = 0; i < 16; ++i) { p0[i] = fast_exp2(p0[i] * f - mref); p1[i] = fast_exp2(p1[i] * f - mref); sm += p0[i] + p1[i]; }
        lsum += sm;
        pk[mt][0] = (u32x4){cvtpk(p0[0], p0[1]), cvtpk(p0[2], p0[3]), cvtpk(p0[4], p0[5]), cvtpk(p0[6], p0[7])};
        pk[mt][1] = (u32x4){cvtpk(p0[8], p0[9]), cvtpk(p0[10], p0[11]), cvtpk(p0[12], p0[13]), cvtpk(p0[14], p0[15])};
        pk[mt][2] = (u32x4){cvtpk(p1[0], p1[1]), cvtpk(p1[2], p1[3]), cvtpk(p1[4], p1[5]), cvtpk(p1[6], p1[7])};
        pk[mt][3] = (u32x4){cvtpk(p1[8], p1[9]), cvtpk(p1[10], p1[11]), cvtpk(p1[12], p1[13]), cvtpk(p1[14], p1[15])};
        asm volatile("s_waitcnt vmcnt(0) lgkmcnt(0)" ::: "memory");
        __syncthreads();
        if (mt < 2) MEM_DMA_K(kb, mt + 2, mt & 1);
    }
    if (kb_next != nullptr) { MEM_DMA_K(kb_next, 0, 0); MEM_DMA_K(kb_next, 1, 1);
        const bf16* qrn = qm_next + (size_t)(32 * wave + c) * DM + 8 * hi;
#pragma unroll
        for (int s = 0; s < 16; ++s) glds16((const char*)(qrn + 16 * s), (unsigned)__builtin_amdgcn_readfirstlane((int)(lds0 + ML_B + 2 * ML_BBUF + wdst))); }
    const float linv = fast_rcp(half_sum(lsum));
    bf16* orow = omem + (size_t)(tl0 + 32 * wave + c) * DM + hm * MHD + 4 * hi;
    const int vx = (c >> 1) & 7;
    f32x16 o[4];
#pragma unroll
    for (int it = 0; it < 8; ++it) {
        const int dh = it >> 2, mt = it & 3, j = it >> 1;
        if (mt == 0) {
#pragma unroll
            for (int dt = 0; dt < 4; ++dt)
#pragma unroll
                for (int i = 0; i < 16; ++i) o[dt][i] = 0.f;
        }
        const LAS unsigned char* va = lds + ML_B + (j & 1) * ML_BBUF + (it & 1) * 16384 + c * 128;
#pragma unroll
        for (int ks = 0; ks < 4; ++ks) {
            const bf16x8_t pb = __builtin_bit_cast(bf16x8_t, pk[mt][ks]);
#pragma unroll
            for (int dt = 0; dt < 4; ++dt) {
                const bf16x8_t vf = *(const LAS bf16x8_t*)(va + dt * 32 * 128 + (((2 * ks + hi) ^ vx) << 4));
                o[dt] = __builtin_amdgcn_mfma_f32_32x32x16_bf16(vf, pb, o[dt], 0, 0, 0);
            }
            __builtin_amdgcn_sched_group_barrier(0x100, 4, 0); __builtin_amdgcn_sched_group_barrier(0x008, 4, 0); __builtin_amdgcn_sched_barrier(0);
        }
        if (it & 1) asm volatile("s_waitcnt vmcnt(0)" ::: "memory");
        if (mt == 3) {
#pragma unroll
            for (int dt = 0; dt < 4; ++dt)
#pragma unroll
                for (int q4 = 0; q4 < 4; ++q4) {
                    u32x2 w; w.x = cvtpk(o[dt][4 * q4] * linv, o[dt][4 * q4 + 1] * linv); w.y = cvtpk(o[dt][4 * q4 + 2] * linv, o[dt][4 * q4 + 3] * linv);
                    *(u32x2*)(orow + 128 * dh + 32 * dt + 8 * q4) = w;
                }
        }
        if (it & 1) {
            asm volatile("s_waitcnt lgkmcnt(0)" ::: "memory");
            __syncthreads();
            if (j < 2) MEM_DMA_V(j + 2, j & 1);
        }
    }
#undef MEM_DMA_K
#undef MEM_DMA_V
}

#define ssq0 ((float*)(ws + OFF_SSQ0))
#define ssq1 ((float*)(ws + OFF_SSQ1))
#define ssq2 ((float*)(ws + OFF_SSQ2))
#define bias1 ((float*)(ws + OFF_BIAS1))
#define WC2T ((bf16*)(ws + OFF_WC2T))
#define W1T ((bf16*)(ws + WS_W1T))
#define W2T ((bf16*)(ws + WS_W2T))
#define WINT ((bf16*)(ws + WS_WINT))
#define WOT ((bf16*)(ws + WS_WOT))
#define W3T ((bf16*)(ws + WS_W3T))
#define W4T ((bf16*)(ws + WS_W4T))
#define WC1T ((bf16*)(ws + WS_WC1T))
#define WMKVT ((bf16*)(ws + WS_WMKVT))
#define MEMN ((bf16*)(ws + WS_MEMN))
#define KM ((bf16*)(ws + WS_KM))
#define VM ((bf16*)(ws + WS_VM))
#define KCMP ((bf16*)(ws + WS_KCMP))
#define HID ((bf16*)(ws + WS_HID))
#define ACT ((bf16*)(ws + WS_A))
#define MG ((unsigned char*)(ws + WS_MG))
#define GB ((bf16*)(ws + WS_GB))
#define UB ((bf16*)(ws + WS_U))
#define QM ((bf16*)out + (size_t)T * DM)
#define XB ((bf16*)(ws + WS_XB))
#define QN ((bf16*)out)
#define KV ((bf16*)(ws + WS_KV))
#define GATES ((float*)(ws + WS_GATES))
#define MERGED ((bf16*)(ws + WS_MERGED))
#define OMEM QM


typedef __attribute__((address_space(1))) unsigned gu32;
#define XB_TMO      128
#define XB_XCNT(j)  (256  + 64 * (j))
#define XB_XSUB(j)  (1280 + 64 * (j))
#define XB_XGEN(j)  (2304 + 64 * (j))
#define XB_TOP      3328
#define XB_TOPGEN   3392
#define XCD_BAR_WORDS 3456
#define XB_SPIN_CAP (1u << 18)

__device__ __forceinline__ unsigned xb_ld(unsigned* p)              { return __hip_atomic_load(p, __ATOMIC_RELAXED, __HIP_MEMORY_SCOPE_AGENT); }
__device__ __forceinline__ unsigned xb_add(unsigned* p, unsigned v) { return __hip_atomic_fetch_add(p, v, __ATOMIC_RELAXED, __HIP_MEMORY_SCOPE_AGENT); }
__device__ __forceinline__ unsigned xb_xcc_id() { return (unsigned)__builtin_amdgcn_s_getreg((3 << 11) | 20) & 0xFu; }
#define XB_SPIN(cond, bar) do { unsigned _sp = 0; while (cond) { __builtin_amdgcn_s_sleep(1); \
    if ((++_sp & 255u) == 0u) { if (xb_ld(&(bar)[XB_TMO])) break; if (_sp > XB_SPIN_CAP) { atomicAdd(&(bar)[XB_TMO], 1u); break; } } } } while (0)

struct XcdBarrier {
    unsigned* bar; unsigned x; int wv;
    volatile LAS unsigned* st;
};

__device__ __forceinline__ XcdBarrier xcd_barrier_post(unsigned* bar, volatile LAS unsigned* st, int wv) {
    XcdBarrier b; b.bar = bar; b.x = xb_xcc_id(); b.st = st; b.wv = wv;
    if (wv == 0 && lane_fresh() == 0) (void)xb_add(&bar[XB_XCNT(b.x)], 1u);
    return b;
}
__device__ __forceinline__ void xcd_barrier_complete(unsigned* bar, unsigned x, unsigned& nloc, unsigned& nx) {
    const unsigned G = gridDim.x * gridDim.y * gridDim.z;
    unsigned sum, cnt, mine, sp = 0u;
    for (;;) {
        sum = 0u; cnt = 0u; mine = 0u;
#pragma unroll
        for (unsigned j = 0; j < 16; ++j) { const unsigned c = xb_ld(&bar[XB_XCNT(j)]); sum += c; cnt += (c > 0u) ? 1u : 0u; mine = (j == x) ? c : mine; }
        if (sum == G) break;
        __builtin_amdgcn_s_sleep(1);
        if ((++sp & 255u) == 0u) { if (xb_ld(&bar[XB_TMO])) break; if (sp > XB_SPIN_CAP) { atomicAdd(&bar[XB_TMO], 1u); break; } }
    }
    nloc = mine > 0u ? mine : 1u; nx = cnt > 0u ? cnt : 1u;
}

__device__ __forceinline__ void xcd_barrier(const XcdBarrier& b) {
    asm volatile("s_waitcnt vmcnt(0)" ::: "memory");
    __syncthreads();
    if (b.wv == 0 && lane_fresh() == 0) {
        unsigned* bar = b.bar; unsigned bx_ = b.x;
        asm volatile("" : "+s"(bar), "+s"(bx_));
        __builtin_amdgcn_s_waitcnt(0);
        unsigned nloc = b.st[0], nx = b.st[1];
        if (nloc == 0u) { xcd_barrier_complete(bar, bx_, nloc, nx); b.st[0] = nloc; b.st[1] = nx; }
        const unsigned old = xb_add(&bar[XB_XSUB(bx_)], 1u);
        const unsigned gen = old / nloc;
        if (old + 1u == (gen + 1u) * nloc) {
            __builtin_amdgcn_fence(__ATOMIC_RELEASE, "agent");
            asm volatile("s_waitcnt vmcnt(0)" ::: "memory");
            const unsigned og = xb_add(&bar[XB_TOP], 1u);
            const unsigned tg = og / nx;
            if (og + 1u == (tg + 1u) * nx) xb_add(&bar[XB_TOPGEN], 1u);
            else XB_SPIN(xb_ld(&bar[XB_TOPGEN]) == tg, bar);
            __builtin_amdgcn_fence(__ATOMIC_ACQUIRE, "agent");
            xb_add(&bar[XB_XGEN(bx_)], 1u);
            asm volatile("s_waitcnt vmcnt(0)" ::: "memory");
        } else {
            XB_SPIN(xb_ld(&bar[XB_XGEN(bx_)]) == gen, bar);
            __builtin_amdgcn_fence(__ATOMIC_ACQUIRE, "agent");
            asm volatile("s_waitcnt vmcnt(0)" ::: "memory");
        }
    }
    __syncthreads();
}


__global__ void __launch_bounds__(512, 2) fwd_megakernel(Args args) {
    extern __shared__ __attribute__((aligned(16))) unsigned char lds_raw[];
    LAS unsigned char* lds = (LAS unsigned char*)lds_raw;
    const int wave = __builtin_amdgcn_readfirstlane((int)threadIdx.x >> 6);
    const int G = gridDim.x, bx = blockIdx.x;
    const int gw = bx * 8 + wave, NGW = G * 8;
    unsigned char* ws = args.ws;
    { volatile LAS unsigned* st = (volatile LAS unsigned*)(lds + LDS_BYTES - 64); const int t_ = wave * 64 + lane_fresh(); if (t_ < 8) st[t_] = 0u; }
    __syncthreads();
    const XcdBarrier bar = xcd_barrier_post((unsigned*)(ws + WS_CTL), (volatile LAS unsigned*)(lds + LDS_BYTES - 64), wave);
    const float* x = args.in[I_X]; float* out = args.out;

    {
        const int lane = lane_fresh();
        LAS float* scr = (LAS float*)(lds + wave * 16640);
        constexpr int I1 = (DM / 64) * (FF2 / 64), I2 = (FF / 64) * (DM / 64), I3 = (DM / 64) * (INWP / 64), I4 = (DM / 64) * (DM / 64);
        constexpr int I7 = (2048 / 64) * (256 / 64), I9 = (DM / 64) * (2048 / 64);
        constexpr int NITEMS = I1 + 2 * I7 + I9 + 8;
        for (int it = gw; it < NITEMS; it += NGW) {
            int r = it;
            if (r < I1) { transpose_item64<1>(args.in[I_F1WI], DM, FF2, args.in[I_F1G], W1T, scr, r, lane); continue; } r -= I1;
            if (r < I7) { transpose_item64<0>(args.in[I_W1K], 2048, 256, nullptr, WC1T, scr, r, lane); continue; } r -= I7;
            if (r < I7) { transpose_item64<0>(args.in[I_W1V], 2048, 256, nullptr, WC1T + (size_t)256 * 2048, scr, r, lane); continue; } r -= I7;
            if (r < I9) { transpose_item64<0>(args.in[I_WMKV], DM, 2048, args.in[I_MEMG], WMKVT, scr, r, lane); continue; } r -= I9;
            if (r < 4) { transpose_item64<0>(args.in[I_W2K], 256, 64, nullptr, WC2T, scr, r, lane); continue; } r -= 4;
            transpose_item64<0>(args.in[I_W2V], 256, 64, nullptr, WC2T + 64 * 256, scr, r, lane);
        }
        for (int row = gw; row < T; row += 2 * NGW) {
            const int row2 = row + NGW;
            const bool has2 = row2 < T; const int rb = has2 ? row2 : row;
            const f32x4* xa = (const f32x4*)(x + (size_t)row * DM) + lane; const f32x4* xc = (const f32x4*)(x + (size_t)rb * DM) + lane;
            f32x4 va[4], vb[4];
#pragma unroll
            for (int j = 0; j < 4; ++j) { va[j] = __builtin_nontemporal_load(xa + 64 * j); vb[j] = __builtin_nontemporal_load(xc + 64 * j); }
            float sa = 0.f, sb = 0.f;
            u32x2* oa = (u32x2*)(XB + (size_t)row * DM) + lane; u32x2* ob = (u32x2*)(XB + (size_t)rb * DM) + lane;
#pragma unroll
            for (int j = 0; j < 4; ++j) {
                sa += va[j][0] * va[j][0] + va[j][1] * va[j][1] + va[j][2] * va[j][2] + va[j][3] * va[j][3];
                sb += vb[j][0] * vb[j][0] + vb[j][1] * vb[j][1] + vb[j][2] * vb[j][2] + vb[j][3] * vb[j][3];
                u32x2 w; w.x = pk2(va[j][0], va[j][1]); w.y = pk2(va[j][2], va[j][3]); oa[64 * j] = w;
                if (has2) { u32x2 w2; w2.x = pk2(vb[j][0], vb[j][1]); w2.y = pk2(vb[j][2], vb[j][3]); ob[64 * j] = w2; } }
            sa = wave_sum(sa); sb = wave_sum(sb);
            if (lane == 0) { ssq0[row] = sa; ssq1[row] = 0.f; ssq2[row] = 0.f; if (has2) { ssq0[row2] = sb; ssq1[row2] = 0.f; ssq2[row2] = 0.f; } }
        }
        for (int row = gw; row < NB * NMEM; row += NGW) {
            const f32x4* xr = (const f32x4*)(args.in[I_MEM] + (size_t)row * DM) + lane; f32x4 v[4]; float ss = 0.f;
#pragma unroll
            for (int j = 0; j < 4; ++j) { v[j] = xr[64 * j]; ss += v[j][0] * v[j][0] + v[j][1] * v[j][1] + v[j][2] * v[j][2] + v[j][3] * v[j][3]; }
            const float rs = rsqrtf(wave_sum(ss) * (1.f / DM) + EPS);
            u32x2* o8 = (u32x2*)(MEMN + (size_t)row * DM) + lane;
#pragma unroll
            for (int j = 0; j < 4; ++j) { u32x2 w; w.x = pk2(v[j][0] * rs, v[j][1] * rs); w.y = pk2(v[j][2] * rs, v[j][3] * rs); o8[64 * j] = w; }
        }
        for (int o = gw; o < 512; o += NGW) {
            const int kvsel = o >> 8, n = o & 255; const float* pe = args.in[kvsel ? I_PEV : I_PEK]; const float* w1 = args.in[kvsel ? I_W1V : I_W1K];
            float s = 0.f;
            for (int k = lane; k < 2048; k += 64) s += pe[k] * w1[(size_t)k * 256 + n];
            s = wave_sum(s); if (lane == 0) bias1[o] = s;
        }
    }
    xcd_barrier(bar);

    {
        pg8::Gemm g{XB, W1T, T, FF2, DM, DM}; pg8::StaticOrder S; S.init(T, FF2, G, bx);
        EpiSwiglu E{ACT, ssq0};
        pg8::gemm_phase<EpiSwiglu, pg8::StaticOrder, true, true>(lds, g, S, E, wave);
    }
    {
        pg8::Gemm g{MEMN, WMKVT, NB * NMEM, 2048, DM, DM}; pg8::StaticOrder S; S.init(NB * NMEM, 2048, G, bx);
        EpiMemKV E{KM, VM};
        pg8::gemm_phase<EpiMemKV, pg8::StaticOrder, true, true>(lds, g, S, E, wave);
        { constexpr int K2 = (FF / 64) * (DM / 64), K3 = (DM / 64) * (INWP / 64), NK = K2 + K3; const int nkv = (NB * NMEM / 256) * (2048 / 256);
          const bool idle = (G > nkv) ? (bx >= nkv) : true; const int nl = (G > nkv) ? G - nkv : G, il = (G > nkv) ? bx - nkv : bx;
          if (idle) { const int lane = lane_fresh(); LAS float* scr = (LAS float*)(lds + wave * 16640);
            asm volatile("s_waitcnt vmcnt(0) lgkmcnt(0)" ::: "memory"); __syncthreads();
            for (int it = il * 8 + wave; it < NK; it += nl * 8) { int r = it;
                if (r < K2) { transpose_item64<0>(args.in[I_F1WO], FF, DM, nullptr, W2T, scr, r, lane); continue; } r -= K2;
                transpose_item64<2>(args.in[I_WIN], DM, INW, args.in[I_MIXG], WINT, scr, r, lane); } } }
    }
    xcd_barrier(bar);

    {
        const int lane_ = lane_fresh();
        for (int row = gw; row < NB * MH * NMEM; row += NGW) {
            bf16* kr = KM + (size_t)row * MHD + lane_ * 4; const u32x2 w = *(const u32x2*)kr;
            float k[4]; k[0] = __uint_as_float(w.x << 16); k[1] = __uint_as_float(w.x & 0xffff0000u); k[2] = __uint_as_float(w.y << 16); k[3] = __uint_as_float(w.y & 0xffff0000u);
            const float rs = rsqrtf(wave_sum(k[0] * k[0] + k[1] * k[1] + k[2] * k[2] + k[3] * k[3]) * (1.f / MHD) + EPS);
            const f32x4 gk = *(const f32x4*)(args.in[I_MKG] + lane_ * 4), gq = *(const f32x4*)(args.in[I_MQG] + lane_ * 4);
            u32x2 o; o.x = pk2(k[0] * rs * gk[0] * gq[0], k[1] * rs * gk[1] * gq[1]); o.y = pk2(k[2] * rs * gk[2] * gq[2], k[3] * rs * gk[3] * gq[3]);
            *(u32x2*)kr = o;
        }
        pg8::Gemm g{ACT, W2T, T, DM, FF, FF}; pg8::StaticOrder S; S.init(T, DM, G, bx);
        EpiResidB<false> E{XB, 0.5f, ssq1, nullptr};
        pg8::gemm_phase<EpiResidB<false>, pg8::StaticOrder, true, true>(lds, g, S, E, wave);
    }
    xcd_barrier(bar);

    for (int ch = 0; ch < NCHUNK; ++ch) {
        const int tok0 = ch * TC;
        {
            pg8::Gemm g{XB + (size_t)tok0 * DM, WINT, TC, INWP, DM, DM}; pg8::StaticOrder S; S.init(TC, INWP, G, bx);
            EpiMix E{ssq1 + tok0, args.in[I_QG], args.in[I_KG], QN, KV, GATES, UB, GB, QM, MG};
            pg8::gemm_phase<EpiMix, pg8::StaticOrder, true, true>(lds, g, S, E, wave);
            { constexpr int J1 = (DM / 64) * (FF2 / 64), J2 = (FF / 64) * (DM / 64), J4 = (DM / 64) * (DM / 64), NJ = J1 + J2 + J4;
              const int nwg3 = (TC / 256) * (INWP / 256), rem = nwg3 % G; const bool light = (rem == 0) || (bx >= rem);
              if (light) { const int lane = lane_fresh(); LAS float* scr = (LAS float*)(lds + wave * 16640); const int nl = (rem == 0) ? G : G - rem, il = (rem == 0) ? bx : bx - rem;
                asm volatile("s_waitcnt vmcnt(0) lgkmcnt(0)" ::: "memory"); __syncthreads();
                for (int it = il * 8 + wave; it < NJ; it += nl * 8) { int r = it;
                    if (r < J1) { transpose_item64<1>(args.in[I_F2WI], DM, FF2, args.in[I_F2G], W3T, scr, r, lane); continue; } r -= J1;
                    if (r < J2) { transpose_item64<0>(args.in[I_F2WO], FF, DM, nullptr, W4T, scr, r, lane); continue; } r -= J2;
                    transpose_item64<0>(args.in[I_WOUT], DM, DM, nullptr, WOT, scr, r, lane); } } }
        }
        xcd_barrier(bar);
        {
            constexpr int NU = 2 * BPC * NG * NCMPP / 256;
            pg8::Gemm g{KV, WC1T, NU * 256, 512, 2048, 1024}; pg8::PairOrder S{NU, NU / 2, G, bx};
            EpiHid E{HID, bias1};
            pg8::gemm_phase<EpiHid, pg8::PairOrder, false, true>(lds, g, S, E, wave);
            asm volatile("s_waitcnt vmcnt(0)" ::: "memory");
            __syncthreads();
            const int lane_ = lane_fresh();
            if (bx < NU) {
                const int kvsel = bx / (NU / 2); const int c = lane_ & 31, hi = lane_ >> 5; const int row = bx * 256 + wave * 32 + c;
                const bf16* hrow = HID + (size_t)row * 256 + 8 * hi; const bf16* wrow = WC2T + (size_t)kvsel * 64 * 256 + (size_t)c * 256 + 8 * hi;
                f32x16 a0, a1;
#pragma unroll
                for (int i = 0; i < 16; ++i) { a0[i] = 0.f; a1[i] = 0.f; }
                bf16x8_t hbv[16], w0v[16], w1v[16];
#pragma unroll
                for (int s2 = 0; s2 < 16; ++s2) { hbv[s2] = *(const bf16x8_t*)(hrow + 16 * s2); w0v[s2] = *(const bf16x8_t*)(wrow + 16 * s2); w1v[s2] = *(const bf16x8_t*)(wrow + 32 * 256 + 16 * s2); }
                __builtin_amdgcn_sched_barrier(0);
#pragma unroll
                for (int s2 = 0; s2 < 16; ++s2) {
                    a0 = __builtin_amdgcn_mfma_f32_32x32x16_bf16(w0v[s2], hbv[s2], a0, 0, 0, 0);
                    a1 = __builtin_amdgcn_mfma_f32_32x32x16_bf16(w1v[s2], hbv[s2], a1, 0, 0, 0);
                }
                if (kvsel == 0) {
                    float ss = 0.f;
#pragma unroll
                    for (int i = 0; i < 16; ++i) ss += a0[i] * a0[i] + a1[i] * a1[i];
                    const float rs = rsqrtf(half_sum(ss) * (1.f / 64.f) + EPS);
#pragma unroll
                    for (int i = 0; i < 16; ++i) { a0[i] *= rs * args.in[I_KG][crow(i, hi)]; a1[i] *= rs * args.in[I_KG][32 + crow(i, hi)]; }
                }
                const float keep = ((row & (NCMPP - 1)) == NCMP) ? 0.f : 1.f;
                bf16* orow = KCMP + (size_t)row * 64 + 4 * hi;
#pragma unroll
                for (int q4 = 0; q4 < 4; ++q4) {
                    u32x2 w0; w0.x = cvtpk(a0[4 * q4] * keep, a0[4 * q4 + 1] * keep); w0.y = cvtpk(a0[4 * q4 + 2] * keep, a0[4 * q4 + 3] * keep);
                    u32x2 w1; w1.x = cvtpk(a1[4 * q4] * keep, a1[4 * q4 + 1] * keep); w1.y = cvtpk(a1[4 * q4 + 2] * keep, a1[4 * q4 + 3] * keep);
                    *(u32x2*)(orow + 8 * q4) = w0; *(u32x2*)(orow + 32 + 8 * q4) = w1;
                }
            } else {
                float gmax = 0.f;
                { const f32x4 gk = *(const f32x4*)(args.in[I_MKG] + lane_ * 4), gq = *(const f32x4*)(args.in[I_MQG] + lane_ * 4);
                  gmax = wave_max(fmaxf(fmaxf(fabsf(gk[0] * gq[0]), fabsf(gk[1] * gq[1])), fmaxf(fabsf(gk[2] * gq[2]), fabsf(gk[3] * gq[3])))); }
                const float mrefm = 16.f * gmax * LOG2E * 1.02f;
                bf16x8_t qfm[16];
                for (int u = bx - NU; u < BPC * MH * (SEQ / 256); u += G - NU) { const int bl = u >> 7, hm = (u >> 5) & 3, tb = u & 31;
                    const int un = u + (G - NU); const bf16* kbn = (un < BPC * MH * (SEQ / 256)) ? KM + (size_t)((ch * BPC + (un >> 7)) * MH + ((un >> 5) & 3)) * NMEM * MHD : nullptr;
                    const bf16* qmn = (kbn != nullptr) ? QM + (size_t)((un >> 7) * SEQ + (un & 31) * 256) * DM + ((un >> 5) & 3) * MHD : nullptr;
                    mem_unit_lds(QM, KM, VM, OMEM, lds, bl * SEQ + tb * 256, ch * BPC + bl, hm, mrefm, wave, u == bx - NU, kbn, qfm, qmn); }
            }
        }
        xcd_barrier(bar);
        {
            NsaU U; U.qn = QN; U.kv = KV; U.kcmp = KCMP; U.gates = GATES; U.onsa = QN; U.relb = args.in[I_RELB]; U.kbound = 0.f;
            const int v = (G % 8 == 0) ? (bx % 8) * (G / 8) + bx / 8 : bx;
            for (int uu = v; uu < BPC * NG * 32; uu += G) {
                const int bg = uu >> 5, s5 = uu & 31;
                { LAS float* lut = (LAS float*)(lds + NL_LUT); const int g = bg & 3;
                  const int tid = wave * 64 + lane_fresh();
                  __syncthreads();
                  for (int i = tid; i < 4 * 129; i += 512) { const int rr = i / 129, n = i - rr * 129; lut[rr * LUTS + 1 + n] = args.in[I_RELB][rel_bucket(n) * NH + g * 4 + rr] * LOG2E; }
                  if (tid < 4) { float bm = -1e30f; for (int b_ = 0; b_ < 32; ++b_) bm = fmaxf(bm, args.in[I_RELB][b_ * NH + g * 4 + tid] * LOG2E); lut[tid * LUTS + 130] = bm; lut[tid * LUTS] = -1e30f;  }
                  if (tid < 64) { const float kmax_ = wave_max(fabsf(args.in[I_KG][tid])); if (tid == 0) lut[131] = 8.f * kmax_ * 1.01f; }
                  LAS float* rl = (LAS float*)(lds + NL_RLUT);
                  for (int i = tid; i < 4 * 256; i += 512) { const int rr = i >> 8, xx = i & 255, dist = 191 - xx;
                      rl[rr * RLS + xx] = dist < 0 ? -1e30f : args.in[I_RELB][rel_bucket(dist > 128 ? 128 : dist) * NH + g * 4 + rr] * LOG2E; }
                  __syncthreads(); }
#pragma unroll 1
                for (int k = 0; k < 4; ++k) { const int qb = (k == 0) ? s5 : (k == 1) ? 63 - s5 : (k == 2) ? 64 + s5 : 127 - s5;
                    nsa_unit(U, lds, bg >> 2, bg & 3, qb, wave); }
            }
        }
        xcd_barrier(bar);
        {
            const float* cw = args.in[I_CONVW]; const float* cb = args.in[I_CONVB];
            const int tid_ = wave * 64 + lane_fresh();
            struct Raw { u32x4 u2, u1, u0, gb, on, om; u32x2 a8, b8, c8; };
            auto ldraw = [&](const int tl, const int c0, Raw& r) {
                const int s = tl & (SEQ - 1); const u32x4 z4 = {0u, 0u, 0u, 0u};
                r.u2 = *(const u32x4*)(UB + (size_t)tl * DM + c0);
                r.u1 = (s >= 1) ? *(const u32x4*)(UB + (size_t)(tl - 1) * DM + c0) : z4;
                r.u0 = (s >= 2) ? *(const u32x4*)(UB + (size_t)(tl - 2) * DM + c0) : z4;
                r.gb = __builtin_nontemporal_load((const u32x4*)(GB + (size_t)tl * DM + c0));
                r.a8 = __builtin_nontemporal_load((const u32x2*)(MG + (size_t)tl * 3072 + c0)); r.b8 = __builtin_nontemporal_load((const u32x2*)(MG + (size_t)tl * 3072 + 1024 + c0)); r.c8 = __builtin_nontemporal_load((const u32x2*)(MG + (size_t)tl * 3072 + 2048 + c0));
                r.on = __builtin_nontemporal_load((const u32x4*)(QN + (size_t)tl * DM + c0));
                r.om = __builtin_nontemporal_load((const u32x4*)(OMEM + (size_t)tl * DM + c0)); };
            auto finish = [&](const int tl, const int c0, const Raw& r) {
                float u0[8], u1[8], u2[8], gbv[8], gn[8], gc[8], gm[8], on[8], om[8];
                unpack8(r.u2, u2); unpack8(r.u1, u1); unpack8(r.u0, u0); unpack8(r.gb, gbv); unpack8(r.on, on); unpack8(r.om, om);
#pragma unroll
                for (int e = 0; e < 4; ++e) { const float k255 = 1.f / 255.f;
                    gn[e] = (float)((r.a8.x >> (8 * e)) & 255u) * k255; gn[4 + e] = (float)((r.a8.y >> (8 * e)) & 255u) * k255;
                    gc[e] = (float)((r.b8.x >> (8 * e)) & 255u) * k255; gc[4 + e] = (float)((r.b8.y >> (8 * e)) & 255u) * k255;
                    gm[e] = (float)((r.c8.x >> (8 * e)) & 255u) * k255; gm[4 + e] = (float)((r.c8.y >> (8 * e)) & 255u) * k255; }
                float o[8];
#pragma unroll
                for (int e = 0; e < 8; ++e) { const int c = c0 + e;
                    const float y = cw[c] * u0[e] + cw[DM + c] * u1[e] + cw[2 * DM + c] * u2[e] + cb[c];
                    o[e] = gn[e] * on[e] + gc[e] * (gbv[e] * y) + gm[e] * om[e]; }
                u32x4 w; w.x = pk2(o[0], o[1]); w.y = pk2(o[2], o[3]); w.z = pk2(o[4], o[5]); w.w = pk2(o[6], o[7]);
                *(u32x4*)(MERGED + (size_t)(tok0 + tl) * DM + c0) = w; };
            for (size_t idx = (size_t)bx * 512 + tid_; idx < (size_t)TC * 128; idx += (size_t)G * 1024) {
                const size_t idxb = idx + (size_t)G * 512; const bool hasb = idxb < (size_t)TC * 128;
                const int tla = (int)(idx >> 7), c0 = (int)(idx & 127) * 8, tlb = hasb ? (int)(idxb >> 7) : tla;
                Raw ra, rb; ldraw(tla, c0, ra); ldraw(tlb, c0, rb);
                __builtin_amdgcn_sched_barrier(0);
                finish(tla, c0, ra); if (hasb) finish(tlb, c0, rb);
            }
        }
        xcd_barrier(bar);
    }

    {
        pg8::Gemm g{MERGED, WOT, T, DM, DM, DM}; pg8::StaticOrder S; S.init(T, DM, G, bx);
        EpiResidB<false> E{XB, 1.0f, ssq2, nullptr};
        pg8::gemm_phase<EpiResidB<false>, pg8::StaticOrder, true, true>(lds, g, S, E, wave);
    }
    xcd_barrier(bar);
    {
        pg8::Gemm g{XB, W3T, T, FF2, DM, DM}; pg8::StaticOrder S; S.init(T, FF2, G, bx);
        EpiSwiglu E{ACT, ssq2};
        pg8::gemm_phase<EpiSwiglu, pg8::StaticOrder, true, true>(lds, g, S, E, wave);
    }
    xcd_barrier(bar);
    {
        pg8::Gemm g{ACT, W4T, T, DM, FF, FF}; pg8::StaticOrder S; S.init(T, DM, G, bx);
        EpiResidB<true> E{XB, 0.5f, nullptr, out};
        pg8::gemm_phase<EpiResidB<true>, pg8::StaticOrder, true, true>(lds, g, S, E, wave);
    }
}

extern "C" void kernel_launch(void* const* d_in, const int* in_sizes, int n_in, void* d_out, int out_size, void* d_ws, size_t ws_size, hipStream_t stream) {
    static int grid = 0;
    if (grid == 0) {
        if (n_in != 26 || in_sizes[0] != T * DM || out_size != T * DM || ws_size < WS_END) {
            fprintf(stderr, "kernel_launch: unexpected shapes (n_in %d, in0 %d, out %d, ws %zu < %zu); nothing launched\n", n_in, n_in > 0 ? in_sizes[0] : -1, out_size, ws_size, (size_t)WS_END);
            grid = -1; return; }
        int dev = 0, cus = 0, per_cu = 0;
        (void)hipGetDevice(&dev); (void)hipDeviceGetAttribute(&cus, hipDeviceAttributeMultiprocessorCount, dev);
        (void)hipFuncSetAttribute((const void*)fwd_megakernel, hipFuncAttributeMaxDynamicSharedMemorySize, LDS_BYTES);
        (void)hipOccupancyMaxActiveBlocksPerMultiprocessor(&per_cu, (const void*)fwd_megakernel, 512, LDS_BYTES);
        if (per_cu < 1) { fprintf(stderr, "kernel_launch: occupancy query says %d blocks per CU\n", per_cu); per_cu = 1; }
        (void)hipGetLastError();
        grid = cus;
        if (grid != 256) fprintf(stderr, "kernel_launch: note: %d CUs\n", grid);
    }
    if (grid < 0) return;
    Args a{};
    for (int i = 0; i < 26; ++i) a.in[i] = (const float*)d_in[i];
    a.out = (float*)d_out; a.ws = (unsigned char*)d_ws;
    if (hipMemsetAsync((char*)d_ws + WS_CTL, 0, 16384, stream) != hipSuccess) { fprintf(stderr, "kernel_launch: hipMemsetAsync failed\n"); return; }
    hipLaunchKernelGGL(fwd_megakernel, dim3(grid), dim3(512), LDS_BYTES, stream, a);
    const hipError_t e = hipPeekAtLastError();
    if (e != hipSuccess) fprintf(stderr, "kernel_launch: launch failed: %s (grid %d)\n", hipGetErrorString(e), grid);
}
```
